# Optimizing an MI355X kernel written in HIP

```python
import jax, jax.numpy as jnp
from jax import lax
import numpy as np

D_MODEL = 1024
BATCH = 8
SEQ = 4096
DEPTH = 4

CTX_LEN = 256
GRID_W = 64
N_MOD = 6
ATTN_WIDTH = 512
ATTN_HEADS = 8
ATTN_HEAD_DIM = ATTN_WIDTH // ATTN_HEADS
ATTN_KV_HEADS = 2
ATTN_GROUP = ATTN_HEADS // ATTN_KV_HEADS
KV_WIDTH = ATTN_KV_HEADS * ATTN_HEAD_DIM
Q_BLOCK = 128
ROPE_THETA = 10000.0
ROPE_AXIS_DIM = ATTN_HEAD_DIM // 2
MLSTM_WIDTH = D_MODEL - ATTN_WIDTH
MLSTM_HEADS = 4
MLSTM_HEAD_DIM = MLSTM_WIDTH // MLSTM_HEADS
MLSTM_CHUNK = 128
CONV_WIDTH = 3
N_GATES = 4 * MLSTM_HEADS
FFN_DIM = 4 * D_MODEL
NORM_EPS = 1e-6
IN_COLS = ATTN_WIDTH + 2 * KV_WIDTH + 4 * MLSTM_WIDTH + N_GATES
SPLIT_IDX = (
    ATTN_WIDTH,
    ATTN_WIDTH + KV_WIDTH,
    ATTN_WIDTH + 2 * KV_WIDTH,
    ATTN_WIDTH + 2 * KV_WIDTH + 2 * MLSTM_WIDTH,
    ATTN_WIDTH + 2 * KV_WIDTH + 3 * MLSTM_WIDTH,
    ATTN_WIDTH + 2 * KV_WIDTH + 4 * MLSTM_WIDTH,
)

kernel_name = "hybrid_mlstm_gqa_dit_block"


def _rmsnorm(x, gain):
    xf = x.astype(jnp.float32)
    y = xf * lax.rsqrt(jnp.mean(xf * xf, axis=-1, keepdims=True) + NORM_EPS)
    return (y * gain.astype(jnp.float32)).astype(x.dtype)


def _modulate(x, gain, shift, scale):
    return _rmsnorm(x, gain) * (1 + scale) + shift


def _axial_rope_tables(n_tokens):
    rows = n_tokens // GRID_W
    row_idx = jnp.repeat(jnp.arange(rows, dtype=jnp.float32), GRID_W)
    col_idx = jnp.tile(jnp.arange(GRID_W, dtype=jnp.float32), rows)
    inv_freq = jnp.power(ROPE_THETA, -jnp.arange(0, ROPE_AXIS_DIM, 2, dtype=jnp.float32) / ROPE_AXIS_DIM)
    ang = jnp.concatenate([row_idx[:, None] * inv_freq, col_idx[:, None] * inv_freq], axis=-1)
    return jnp.cos(ang), jnp.sin(ang)


def _apply_rope(x, cos, sin):
    B, T, H, hd = x.shape
    xf = x.astype(jnp.float32).reshape(B, T, H, hd // 2, 2)
    x0, x1 = xf[..., 0], xf[..., 1]
    c = cos[None, :, None, :]
    s = sin[None, :, None, :]
    return jnp.stack([x0 * c - x1 * s, x0 * s + x1 * c], axis=-1).reshape(B, T, H, hd).astype(x.dtype)


def _centred_dwconv(x, w):
    T = x.shape[1]
    pad = (CONV_WIDTH - 1) // 2
    xp = jnp.pad(x, ((0, 0), (pad, pad), (0, 0)))
    return sum(xp[:, j:j + T] * w[j] for j in range(CONV_WIDTH))


def _project_stream(h, w_in, b_gates, conv_w, q_gain, k_gain, rope):
    B, T, _ = h.shape
    p = h @ w_in
    a_q, a_k, a_v, m_qk, m_v, m_o, gates = jnp.split(p, SPLIT_IDX, axis=-1)
    a_q = _rmsnorm(a_q.reshape(B, T, ATTN_HEADS, ATTN_HEAD_DIM), q_gain)
    a_k = _rmsnorm(a_k.reshape(B, T, ATTN_KV_HEADS, ATTN_HEAD_DIM), k_gain)
    a_v = a_v.reshape(B, T, ATTN_KV_HEADS, ATTN_HEAD_DIM)
    if rope is not None:
        cos, sin = rope
        a_q = _apply_rope(a_q, cos, sin)
        a_k = _apply_rope(a_k, cos, sin)
    m_q, m_k = jnp.split(jax.nn.silu(_centred_dwconv(m_qk, conv_w)), 2, axis=-1)

    def heads(t):
        return t.reshape(B, T, MLSTM_HEADS, MLSTM_HEAD_DIM).transpose(0, 2, 1, 3).astype(jnp.float32)

    m_q, m_k, m_v = heads(m_q), heads(m_k) * (MLSTM_HEAD_DIM ** -0.5), heads(m_v)
    g = (gates.astype(jnp.float32) + b_gates.astype(jnp.float32)).transpose(0, 2, 1)
    i_f, f_f, i_b, f_b = jnp.split(g, 4, axis=1)
    fwd = (m_q, m_k, m_v, i_f, jax.nn.log_sigmoid(f_f))
    bwd = (jnp.flip(m_q, 2), jnp.flip(m_k, 2), jnp.flip(m_v, 2),
           jnp.flip(i_b, -1), jax.nn.log_sigmoid(jnp.flip(f_b, -1)))
    return (a_q, a_k, a_v), fwd, bwd, jax.nn.sigmoid(m_o)


def _blocked_attention(q, k, v):
    B, T, HQ, hd = q.shape
    nb = T // Q_BLOCK
    qb = q.reshape(B, nb, Q_BLOCK, ATTN_KV_HEADS, ATTN_GROUP, hd).transpose(1, 0, 2, 3, 4, 5)
    scale = hd ** -0.5

    def block(qblk):
        s = jnp.einsum('bqkgd,bskd->bkgqs', qblk, k, preferred_element_type=jnp.float32) * scale
        p = jax.nn.softmax(s, axis=-1).astype(v.dtype)
        return jnp.einsum('bkgqs,bskd->bqkgd', p, v)

    o = lax.map(block, qb)
    return o.transpose(1, 0, 2, 3, 4, 5).reshape(B, T, HQ * hd)


def _mlstm_init(batch):
    return (jnp.zeros((batch, MLSTM_HEADS, MLSTM_HEAD_DIM, MLSTM_HEAD_DIM), jnp.float32),
            jnp.zeros((batch, MLSTM_HEADS, MLSTM_HEAD_DIM), jnp.float32),
            jnp.zeros((batch, MLSTM_HEADS), jnp.float32))


def _mlstm_scan(q, k, v, ig, lf, state, emit):
    B, H, T, d = q.shape
    nc = T // MLSTM_CHUNK

    def chunks(a):
        return jnp.moveaxis(a.reshape(B, H, nc, MLSTM_CHUNK, *a.shape[3:]), 2, 0)

    tril = jnp.tril(jnp.ones((MLSTM_CHUNK, MLSTM_CHUNK), dtype=bool))

    def step(carry, xs):
        C, n, m = carry
        qc, kc, vc, igc, lfc = xs
        b = jnp.cumsum(lfc, axis=-1)
        b_last = b[..., -1]
        g = b_last[..., None] - b + igc
        m_new = jnp.maximum(b_last + m, jnp.max(g, axis=-1))
        decay = jnp.exp(b_last + m - m_new)
        w = jnp.exp(g - m_new[..., None])
        C_new = decay[..., None, None] * C + jnp.einsum('bhsv,bhsk->bhvk', vc * w[..., None], kc)
        n_new = decay[..., None] * n + jnp.einsum('bhs,bhsk->bhk', w, kc)
        if not emit:
            return (C_new, n_new, m_new), None
        dmat = jnp.where(tril, b[..., :, None] - b[..., None, :] + igc[..., None, :], -jnp.inf)
        m_inter = b + m[..., None]
        m_t = jnp.maximum(m_inter, jnp.max(dmat, axis=-1))
        w_inter = jnp.exp(m_inter - m_t)
        s = jnp.einsum('bhtk,bhsk->bhts', qc, kc) * jnp.exp(dmat - m_t[..., None])
        num = w_inter[..., None] * jnp.einsum('bhvk,bhtk->bhtv', C, qc) + jnp.einsum('bhts,bhsv->bhtv', s, vc)
        den = w_inter * jnp.einsum('bhk,bhtk->bht', n, qc) + jnp.sum(s, axis=-1)
        h = num / jnp.maximum(jnp.abs(den), jnp.exp(-m_t))[..., None]
        return (C_new, n_new, m_new), h

    state, hs = lax.scan(step, state, tuple(chunks(a) for a in (q, k, v, ig, lf)))
    if not emit:
        return None, state
    return jnp.moveaxis(hs, 0, 2).reshape(B, H, T, d), state


def _merge_mlstm(h_f, h_b, o, gain):
    B, H, T, d = h_f.shape
    h = (h_f + h_b).transpose(0, 2, 1, 3)
    h = _rmsnorm(h, gain.reshape(H, d)).reshape(B, T, H * d)
    return (o * h).astype(o.dtype)


def _hybrid_mixer(h_lat, h_ctx, w_in, b_gates, conv_w, q_gain, k_gain, ml_gain, w_out, rope, emit_ctx):
    attn_l, fwd_l, bwd_l, o_l = _project_stream(h_lat, w_in, b_gates, conv_w, q_gain, k_gain, rope)
    attn_c, fwd_c, bwd_c, o_c = _project_stream(h_ctx, w_in, b_gates, conv_w, q_gain, k_gain, None)
    q_l, k_l, v_l = attn_l
    q_c, k_c, v_c = attn_c
    att_l = _blocked_attention(q_l, jnp.concatenate([k_c, k_l], axis=1), jnp.concatenate([v_c, v_l], axis=1))
    init = _mlstm_init(h_lat.shape[0])
    hc_f, st_f = _mlstm_scan(*fwd_c, init, emit_ctx)
    hc_b, st_b = _mlstm_scan(*bwd_c, init, emit_ctx)
    hl_f, _ = _mlstm_scan(*fwd_l, st_f, True)
    hl_b, _ = _mlstm_scan(*bwd_l, st_b, True)
    mem_l = _merge_mlstm(hl_f, jnp.flip(hl_b, 2), o_l, ml_gain)
    y_lat = jnp.concatenate([att_l, mem_l.astype(att_l.dtype)], axis=-1) @ w_out
    if not emit_ctx:
        return y_lat, None
    att_c = _blocked_attention(q_c, k_c, v_c)
    mem_c = _merge_mlstm(hc_f, jnp.flip(hc_b, 2), o_c, ml_gain)
    y_ctx = jnp.concatenate([att_c, mem_c.astype(att_c.dtype)], axis=-1) @ w_out
    return y_lat, y_ctx


def _sqrelu_mlp(h, w1, w2):
    return jnp.square(jax.nn.relu(h @ w1)) @ w2


def setup_inputs(seed: int = 0) -> dict:
    key = jax.random.key(seed)
    ks = jax.random.split(key, 20)

    def nrm(k, shape, scale):
        return jax.random.normal(k, shape, jnp.float32) * scale

    f_bias = jnp.linspace(3.0, 6.0, MLSTM_HEADS, dtype=jnp.float32)
    b_gates = jnp.concatenate([
        nrm(ks[9], (DEPTH, MLSTM_HEADS), 0.1),
        f_bias + nrm(ks[10], (DEPTH, MLSTM_HEADS), 0.1),
        nrm(ks[11], (DEPTH, MLSTM_HEADS), 0.1),
        f_bias + nrm(ks[12], (DEPTH, MLSTM_HEADS), 0.1),
    ], axis=-1)
    return {
        "x": nrm(ks[0], (BATCH, SEQ, D_MODEL), 1.0),
        "c": nrm(ks[1], (BATCH, D_MODEL), 1.0),
        "ctx": nrm(ks[2], (BATCH, CTX_LEN, D_MODEL), 1.0),
        "c_ctx": nrm(ks[3], (D_MODEL,), 1.0),
        "w_ada": nrm(ks[4], (DEPTH, D_MODEL, N_MOD * D_MODEL), 0.5 * D_MODEL ** -0.5),
        "b_ada": nrm(ks[5], (DEPTH, N_MOD * D_MODEL), 0.02),
        "norm_mix": 1.0 + nrm(ks[6], (DEPTH, D_MODEL), 0.02),
        "norm_mlp": 1.0 + nrm(ks[7], (DEPTH, D_MODEL), 0.02),
        "w_in": nrm(ks[8], (DEPTH, D_MODEL, IN_COLS), D_MODEL ** -0.5),
        "b_gates": b_gates,
        "conv_qk": nrm(ks[13], (DEPTH, CONV_WIDTH, 2 * MLSTM_WIDTH), CONV_WIDTH ** -0.5),
        "q_norm": 1.0 + nrm(ks[14], (DEPTH, ATTN_HEAD_DIM), 0.02),
        "k_norm": 1.0 + nrm(ks[15], (DEPTH, ATTN_HEAD_DIM), 0.02),
        "mlstm_norm": 1.0 + nrm(ks[16], (DEPTH, MLSTM_WIDTH), 0.02),
        "w_out": nrm(ks[17], (DEPTH, D_MODEL, D_MODEL), D_MODEL ** -0.5),
        "w_mlp_in": nrm(ks[18], (DEPTH, D_MODEL, FFN_DIM), D_MODEL ** -0.5),
        "w_mlp_out": nrm(ks[19], (DEPTH, FFN_DIM, D_MODEL), FFN_DIM ** -0.5),
        "norm_final": 1.0 + nrm(jax.random.fold_in(key, 99), (D_MODEL,), 0.02),
    }


def reference(x, c, ctx, c_ctx, w_ada, b_ada, norm_mix, norm_mlp, w_in, b_gates, conv_qk,
              q_norm, k_norm, mlstm_norm, w_out, w_mlp_in, w_mlp_out, norm_final):
    rope = _axial_rope_tables(x.shape[1])
    silu_c = jax.nn.silu(c)
    silu_cc = jax.nn.silu(c_ctx)
    for layer in range(DEPTH):
        emit_ctx = layer < DEPTH - 1
        mod_l = (silu_c @ w_ada[layer] + b_ada[layer])[:, None, :]
        mod_c = silu_cc @ w_ada[layer] + b_ada[layer]
        sh1, sc1, g1, sh2, sc2, g2 = jnp.split(mod_l, N_MOD, axis=-1)
        csh1, csc1, cg1, csh2, csc2, cg2 = jnp.split(mod_c, N_MOD, axis=-1)
        y_l, y_c = _hybrid_mixer(
            _modulate(x, norm_mix[layer], sh1, sc1),
            _modulate(ctx, norm_mix[layer], csh1, csc1),
            w_in[layer], b_gates[layer], conv_qk[layer], q_norm[layer], k_norm[layer],
            mlstm_norm[layer], w_out[layer], rope, emit_ctx)
        x = x + g1 * y_l
        x = x + g2 * _sqrelu_mlp(_modulate(x, norm_mlp[layer], sh2, sc2), w_mlp_in[layer], w_mlp_out[layer])
        if emit_ctx:
            ctx = ctx + cg1 * y_c
            ctx = ctx + cg2 * _sqrelu_mlp(_modulate(ctx, norm_mlp[layer], csh2, csc2), w_mlp_in[layer], w_mlp_out[layer])
    return _rmsnorm(x, norm_final)
```

```cpp
#include <hip/hip_runtime.h>
#include <hip/hip_cooperative_groups.h>
#include <cstdio>
#include <cstdint>
namespace cg = cooperative_groups;
#ifndef REP_A
#define REP_A 1
#endif
#ifndef REP_B
#define REP_B 1
#endif
#ifndef REP_E
#define REP_E 1
#endif
#ifndef REP_G
#define REP_G 1
#endif
#ifndef REP_H
#define REP_H 1
#endif
#ifndef ATT_REPS
#define ATT_REPS 1
#endif
#ifndef REP_F
#define REP_F 1
#endif
#ifndef REP_I
#define REP_I 1
#endif
#ifndef REP_0
#define REP_0 1
#endif
#ifndef REP_C
#define REP_C 1
#endif
#ifndef REP_Z
#define REP_Z 1
#endif
#ifndef MLSTM_REPS
#define MLSTM_REPS 1
#endif
#ifndef PHMASK
#define PHMASK 0x7ff
#endif
__device__ __forceinline__ int opaque_tid() { int t = threadIdx.x; asm volatile("" : "+v"(t)); return t; }
namespace pg8 {
#define PG8_LAS __attribute__((address_space(3)))
typedef unsigned short bf16_t;
typedef short bf16x8 __attribute__((ext_vector_type(8)));
typedef float f32x4 __attribute__((ext_vector_type(4)));
typedef unsigned u32x4 __attribute__((ext_vector_type(4)));
constexpr int BM = 256, BK = 64, HALF = 128, HTB = HALF * BK * 2  , STAGE_BYTES = 8 * HTB, NXCD = 8, WGM = 8;

__host__ __device__ __forceinline__ int lds_byte(int r, int c) { const int st = (r >> 4) * 2 + (c >> 5), rr = r & 15, cc = c & 31, ob = rr * 64 + cc * 2; return st * 1024 + (ob ^ (((ob >> 9) & 1) << 5)); }
__host__ __device__ __forceinline__ void stage_rc(int b, int& R, int& C) { const int st = b / 1024, sb = b % 1024, swz = sb ^ (((sb >> 9) & 1) << 5); R = (st >> 1) * 16 + swz / 64; C = (st & 1) * 32 + (swz % 64) / 2; }
__host__ __device__ __forceinline__ int perm32(int rho) { const int n = rho >> 4, i = rho & 15; return 8 * (i >> 2) + 4 * n + (i & 3); }

struct Unit { int pm, pn, k0, nt, sl; };
struct Gemm { const bf16_t* A; const bf16_t* Bt; int M, N, K, ablk; };

struct StaticOrder {
    int nM, nN, nwg, G, c, ntf;
    __host__ __device__ void init(int M, int N, int G_, int c_) { nM = M / BM; nN = N / BM; nwg = nM * nN; G = G_; c = c_; }
    __host__ __device__ bool next(int i, Unit& u) const {
        const long L = (long)i * G + c; if (L >= nwg) return false;
        int wgid = (int)L; { const int q = nwg / NXCD, r = nwg % NXCD, xcd = wgid % NXCD, off = wgid / NXCD; wgid = (xcd < r ? xcd * (q + 1) : r * (q + 1) + (xcd - r) * q) + off; }
        const int nig = WGM * nN, gid = wgid / nig, fm = gid * WGM, gsz = (nM - fm) < WGM ? (nM - fm) : WGM;
        u = Unit{fm + ((wgid % nig) % gsz), (wgid % nig) / gsz, 0, ntf, -1}; return true;
    }
    __device__ __forceinline__ void a_ready(const Unit&) const {}
    __device__ __forceinline__ void done(const Unit&) const {}
};
struct ThinLastOrder {
    StaticOrder L; int nthin;
    __host__ __device__ void init(int M, int G_, int c_) { L.init(M, 11 * 256, G_, c_); L.ntf = 16; nthin = M / BM; }
    __host__ __device__ bool next(int i, Unit& u) const {
        const long idx = (long)i * L.G + L.c;
        if (idx < L.nwg) return L.next(i, u);
        const long t = idx - L.nwg; if (t >= nthin) return false;
        u = Unit{(int)t, 11, 0, L.ntf, -1}; return true;
    }
    __device__ __forceinline__ void a_ready(const Unit&) const {}
    __device__ __forceinline__ void done(const Unit&) const {}
};
struct SplitOrder {
    StaticOrder L; int rl, nsplit;
    __host__ __device__ void init(int G_, int c_, int K, bool with_ctx) { L.init(32768, 1024, G_, c_); L.ntf = K / 64; rl = (c_ < L.nwg) ? (L.nwg - c_ + G_ - 1) / G_ : 0; nsplit = with_ctx ? 256 : 0; }
    __host__ __device__ bool next(int i, Unit& u) const {
        if (i < rl) return L.next(i, u);
        const int j = i - rl; const long sidx = (long)j * L.G + L.c; if (sidx >= nsplit) return false;
        const int tile = (int)sidx >> 3, slice = (int)sidx & 7, nts = L.ntf / 8; u = Unit{128 + (tile >> 2), tile & 3, slice * nts * 64, nts, slice}; return true;
    }
    __device__ __forceinline__ void a_ready(const Unit&) const {}
    __device__ __forceinline__ void done(const Unit&) const {}
};

__device__ __forceinline__ unsigned cvt_pk_bf16(float lo, float hi) { unsigned r; asm volatile("v_cvt_pk_bf16_f32 %0, %1, %2" : "=v"(r) : "v"(lo), "v"(hi)); return r; }
typedef float f32x2 __attribute__((ext_vector_type(2)));
__device__ __forceinline__ f32x2 gelu_pk(f32x2 v) {
    const f32x2 av = __builtin_elementwise_abs(v), d = av * 0.2316418882f + 1.0f;
    f32x2 t; t.x = __builtin_amdgcn_rcpf(d.x); t.y = __builtin_amdgcn_rcpf(d.y);
    f32x2 q = t * 0.5307027145f + (-0.7265760135f); q = q * t + 0.7107068705f; q = q * t + (-0.142248368f); q = q * t + 0.127414796f; q = q * t;
    const f32x2 s = (v * v) * (-0.72134752044f);
    f32x2 e; e.x = __builtin_amdgcn_exp2f(s.x); e.y = __builtin_amdgcn_exp2f(s.y);
    const f32x2 m = v * (q * e), r = v - m;
    f32x2 o; o.x = v.x < 0.f ? m.x : r.x; o.y = v.y < 0.f ? m.y : r.y; return o;
}

constexpr int ML_ROWS = 32768;
struct EpiIn {
    static constexpr bool PERM = true, AFTER_DRAIN = false;
    bf16_t* AO; bf16_t* PM; bf16_t* RAW; float* gates; const float* bg;
    __device__ __forceinline__ void operator()(const f32x4 (&acc)[2][2][4][2], const Unit& u, int wr, int wc, int fr, int fq) const {
        const int row0 = u.pm * BM + wr * 64 + fr;
        if (u.pn < 11) {
            bf16_t* base; int ldc, colt;
            if (u.pn < 3) { base = AO; ldc = 1024; colt = u.pn * 256; } else if (u.pn < 7) { base = RAW; ldc = 1024; colt = (u.pn - 3) * 256; } else { base = PM; ldc = 2048; colt = (u.pn - 3) * 256; }
            const int col0 = colt + wc * 32 + 8 * fq;
#pragma unroll
            for (int ai = 0; ai < 2; ++ai)
#pragma unroll
                for (int m = 0; m < 4; ++m) { bf16_t* rowp = base + (size_t)(row0 + ai * HALF + m * 16) * ldc + col0;
#pragma unroll
                    for (int bj = 0; bj < 2; ++bj) { const f32x4 v0 = acc[ai][bj][m][0], v1 = acc[ai][bj][m][1];
                        u32x4 w; w.x = cvt_pk_bf16(v0[0], v0[1]); w.y = cvt_pk_bf16(v0[2], v0[3]); w.z = cvt_pk_bf16(v1[0], v1[1]); w.w = cvt_pk_bf16(v1[2], v1[3]);
                        *(u32x4*)(rowp + bj * HALF) = w; } }
        } else {
            if (wc == 0 && fq < 2) {
                const f32x4 b0 = *(const f32x4*)(bg + 8 * fq), b1 = *(const f32x4*)(bg + 8 * fq + 4);
#pragma unroll
                for (int ai = 0; ai < 2; ++ai)
#pragma unroll
                    for (int m = 0; m < 4; ++m) { float* rowp = gates + (size_t)(row0 + ai * HALF + m * 16) * 16 + 8 * fq;
                        *(f32x4*)(rowp) = acc[ai][0][m][0] + b0; *(f32x4*)(rowp + 4) = acc[ai][0][m][1] + b1; }
            }
        }
    }
};
struct EpiRes {
    static constexpr bool PERM = true, AFTER_DRAIN = false;
    const void* xlat; const void* xctx; bf16_t* X; const float* gmod; unsigned rowmask; bf16_t* PART; int xbf;
    __device__ __forceinline__ void operator()(const f32x4 (&acc)[2][2][4][2], const Unit& u, int wr, int wc, int fr, int fq) const {
        const int row0 = u.pm * BM + wr * 64 + fr;
        const int mr = (u.pm < 128) ? (u.pm >> 4) : 8;
        const int col0 = u.pn * BM + wc * 32 + 8 * fq;
        const float* gp = gmod + (size_t)mr * 6144 + col0;
        if (u.sl >= 0) {
            bf16_t* pp = PART + ((size_t)u.sl * 2048 + (row0 - ML_ROWS)) * 1024 + col0;
#pragma unroll
            for (int ai = 0; ai < 2; ++ai)
#pragma unroll
                for (int m = 0; m < 4; ++m)
#pragma unroll
                    for (int bj = 0; bj < 2; ++bj) { bf16_t* q = pp + (size_t)(ai * HALF + m * 16) * 1024 + bj * HALF; const f32x4 v0 = acc[ai][bj][m][0], v1 = acc[ai][bj][m][1];
                        u32x4 w; w.x = cvt_pk_bf16(v0[0], v0[1]); w.y = cvt_pk_bf16(v0[2], v0[3]); w.z = cvt_pk_bf16(v1[0], v1[1]); w.w = cvt_pk_bf16(v1[2], v1[3]); *(u32x4*)q = w; }
            return;
        }
        f32x4 gv[2][2];
#pragma unroll
        for (int bj = 0; bj < 2; ++bj) { gv[bj][0] = *(const f32x4*)(gp + bj * HALF); gv[bj][1] = *(const f32x4*)(gp + bj * HALF + 4); }
        if (xbf) {
#pragma unroll
            for (int ai = 0; ai < 2; ++ai)
#pragma unroll
                for (int mp = 0; mp < 2; ++mp) {
                    u32x4 xr[2][2];
#pragma unroll
                    for (int mm = 0; mm < 2; ++mm) { const int row = row0 + ai * HALF + (2 * mp + mm) * 16;
                        const size_t rin = (row < ML_ROWS) ? (size_t)row : (size_t)(row - ML_ROWS);
                        const char* xin = (const char*)((row < ML_ROWS) ? xlat : xctx);
#pragma unroll
                        for (int bj = 0; bj < 2; ++bj) xr[mm][bj] = *(const u32x4*)(xin + (rin * 1024 + col0 + bj * HALF) * 2); }
#pragma unroll
                    for (int mm = 0; mm < 2; ++mm) { const int m = 2 * mp + mm; const int row = row0 + ai * HALF + m * 16;
                        bf16_t* xo = X + (size_t)((unsigned)row & rowmask) * 1024;
#pragma unroll
                        for (int bj = 0; bj < 2; ++bj) { const int c = col0 + bj * HALF; const u32x4 w = xr[mm][bj];
                            const f32x4 a0 = (f32x4){__builtin_bit_cast(float, w.x << 16), __builtin_bit_cast(float, w.x & 0xffff0000u), __builtin_bit_cast(float, w.y << 16), __builtin_bit_cast(float, w.y & 0xffff0000u)};
                            const f32x4 a1 = (f32x4){__builtin_bit_cast(float, w.z << 16), __builtin_bit_cast(float, w.z & 0xffff0000u), __builtin_bit_cast(float, w.w << 16), __builtin_bit_cast(float, w.w & 0xffff0000u)};
                            const f32x4 x0 = a0 + gv[bj][0] * acc[ai][bj][m][0], x1 = a1 + gv[bj][1] * acc[ai][bj][m][1];
                            u32x4 o; o.x = cvt_pk_bf16(x0[0], x0[1]); o.y = cvt_pk_bf16(x0[2], x0[3]); o.z = cvt_pk_bf16(x1[0], x1[1]); o.w = cvt_pk_bf16(x1[2], x1[3]);
                            *(u32x4*)(xo + c) = o; } }
                    asm volatile("" ::: "memory");
                }
        } else {
#pragma unroll
            for (int ai = 0; ai < 2; ++ai)
#pragma unroll
                for (int m = 0; m < 4; ++m) { const int row = row0 + ai * HALF + m * 16;
                    const size_t rin = (row < ML_ROWS) ? (size_t)row : (size_t)(row - ML_ROWS);
                    const char* xin = (const char*)((row < ML_ROWS) ? xlat : xctx);
                    bf16_t* xo = X + (size_t)((unsigned)row & rowmask) * 1024;
#pragma unroll
                    for (int bj = 0; bj < 2; ++bj) { const int c = col0 + bj * HALF;
                        const f32x4 a0 = *(const f32x4*)(xin + (rin * 1024 + c) * 4), a1 = *(const f32x4*)(xin + (rin * 1024 + c) * 4 + 16);
                        const f32x4 x0 = a0 + gv[bj][0] * acc[ai][bj][m][0], x1 = a1 + gv[bj][1] * acc[ai][bj][m][1];
                        u32x4 o; o.x = cvt_pk_bf16(x0[0], x0[1]); o.y = cvt_pk_bf16(x0[2], x0[3]); o.z = cvt_pk_bf16(x1[0], x1[1]); o.w = cvt_pk_bf16(x1[2], x1[3]);
                        *(u32x4*)(xo + c) = o; } }
        }
    }
};
struct EpiUp {
    static constexpr bool PERM = true, AFTER_DRAIN = false;
    bf16_t* H;
    __device__ __forceinline__ void operator()(const f32x4 (&acc)[2][2][4][2], const Unit& u, int wr, int wc, int fr, int fq) const {
        const int row0 = u.pm * BM + wr * 64 + fr; const int col0 = u.pn * BM + wc * 32 + 8 * fq;
#pragma unroll
        for (int ai = 0; ai < 2; ++ai)
#pragma unroll
            for (int m = 0; m < 4; ++m) { const int row = row0 + ai * HALF + m * 16;
                bf16_t* rowp = H + ((size_t)((row >> 8) * 64 + (col0 >> 6)) * 256 + (row & 255)) * 64 + (col0 & 63);
#pragma unroll
                for (int bj = 0; bj < 2; ++bj) { f32x4 v0 = acc[ai][bj][m][0], v1 = acc[ai][bj][m][1];
#pragma unroll
                    for (int e = 0; e < 4; ++e) { const float a = fmaxf(v0[e], 0.f), b = fmaxf(v1[e], 0.f); v0[e] = a * a; v1[e] = b * b; }
                    u32x4 w; w.x = cvt_pk_bf16(v0[0], v0[1]); w.y = cvt_pk_bf16(v0[2], v0[3]); w.z = cvt_pk_bf16(v1[0], v1[1]); w.w = cvt_pk_bf16(v1[2], v1[3]);
                    *(u32x4*)(rowp + (size_t)bj * 2 * 256 * 64) = w; } }
    }
};
template <class Epi, class Sched, bool ALIGN_EPI = false, bool SP2 = false, int THIN_PN = -1>
__device__ __forceinline__ void gemm_phase(PG8_LAS unsigned char* lds, const Gemm g, const Sched& S, const Epi& E) {
    const int tid = opaque_tid(), wid = __builtin_amdgcn_readfirstlane(tid >> 6), lane = tid & 63, wr = wid >> 2, wc = wid & 3, fr = lane & 15, fq = lane >> 4;
    const int K = g.K;
    unsigned voffA[2], voffB[2];
#pragma unroll
    for (int i = 0; i < 2; ++i) { int R, C; stage_rc(tid * 16 + i * 8192, R, C); const int Rb = Epi::PERM ? ((R & ~31) + perm32(R & 31)) : R;
        voffA[i] = (unsigned)(R * (g.ablk ? BK : K) + C) * 2u; voffB[i] = (unsigned)(Rb * K + C) * 2u; }
    const size_t kstep = (size_t)(BK * 2);
    const size_t hstep = (size_t)HALF * K * 2;
    const size_t tstep = 2 * hstep;
    const size_t kstepA = g.ablk ? (size_t)BM * BK * 2 : kstep, hstepA = g.ablk ? (size_t)HALF * BK * 2 : hstep;
    const unsigned ldsw = (unsigned)wid * 1024u;
    const int aoff = lds_byte(wr * 64 + fr, fq * 8), boff = lds_byte(wc * 32 + fr, fq * 8);
#define PG8_SA(b, h) (((b) * 2 + (h)) * HTB)
#define PG8_SB(b, h) ((4 + (b) * 2 + (h)) * HTB)
#define PG8_STAGE(bufoff, gbase, voff) do { _Pragma("unroll") for (int _i = 0; _i < 2; ++_i) \
        __builtin_amdgcn_global_load_lds((const unsigned*)((const char*)(gbase) + (voff)[_i]), (PG8_LAS unsigned*)(lds + (bufoff) + ldsw + _i * 8192), 16, 0, 0); } while (0)
#define PG8_LDA(dst, b, h) do { _Pragma("unroll") for (int m = 0; m < 4; ++m) _Pragma("unroll") for (int k = 0; k < 2; ++k) dst[m][k] = *(const PG8_LAS bf16x8*)(lds + PG8_SA(b, h) + aoff + m * 2048 + k * 1024); } while (0)
#define PG8_LDB(dst, b, h) do { _Pragma("unroll") for (int n = 0; n < 2; ++n) _Pragma("unroll") for (int k = 0; k < 2; ++k) dst[n][k] = *(const PG8_LAS bf16x8*)(lds + PG8_SB(b, h) + boff + n * 2048 + k * 1024); } while (0)
#define PG8_MMA(ai, bj, At, Bt) do { __builtin_amdgcn_s_setprio(1); _Pragma("unroll") for (int m = 0; m < 4; ++m) _Pragma("unroll") for (int n = 0; n < 2; ++n) _Pragma("unroll") for (int k = 0; k < 2; ++k) \
        acc[ai][bj][m][n] = __builtin_amdgcn_mfma_f32_16x16x32_bf16(Bt[n][k], At[m][k], acc[ai][bj][m][n], 0, 0, 0); __builtin_amdgcn_s_setprio(0); } while (0)
#define PG8_MMAT(ai, bj, At, Bt) do { if (THIN_PN < 0 || !(thin && ((bj) != 0 || wc != 0))) PG8_MMA(ai, bj, At, Bt); } while (0)
#define PG8_WAIT_V(n) asm volatile("s_waitcnt vmcnt(" #n ")" ::: "memory")
#define PG8_WAIT_L(n) asm volatile("s_waitcnt lgkmcnt(" #n ")" ::: "memory")
#define PG8_BAR __builtin_amdgcn_s_barrier()
#define PG8_SCHED __builtin_amdgcn_sched_barrier(0)
    Unit cur, nxt; int ui = 0;
    if (!S.next(0, cur)) return;
    f32x4 acc[2][2][4][2];
#pragma unroll
    for (int a = 0; a < 2; ++a)
#pragma unroll
        for (int b = 0; b < 2; ++b)
#pragma unroll
            for (int m = 0; m < 4; ++m)
#pragma unroll
                for (int n = 0; n < 2; ++n) acc[a][b][m][n] = (f32x4){0.f, 0.f, 0.f, 0.f};
    bf16x8 At[4][2], B0[2][2], B1[2][2];
    const char* cA = (const char*)g.A + (size_t)cur.pm * tstep + (size_t)(cur.k0 / BK) * kstepA; const char* cB = (const char*)g.Bt + (size_t)cur.pn * tstep + (size_t)cur.k0 * 2;
    S.a_ready(cur);
    if constexpr (SP2) {
        PG8_STAGE(PG8_SB(0, 0), cB, voffB); PG8_STAGE(PG8_SB(0, 1), cB + hstep, voffB); PG8_STAGE(PG8_SA(0, 0), cA, voffA); PG8_STAGE(PG8_SA(0, 1), cA + hstepA, voffA);
        if (wr == 1) PG8_BAR;
        PG8_WAIT_V(2); PG8_BAR;
        PG8_STAGE(PG8_SB(1, 0), cB + kstep, voffB); PG8_STAGE(PG8_SA(1, 0), cA + kstepA, voffA); PG8_STAGE(PG8_SB(1, 1), cB + hstep + kstep, voffB);
        PG8_WAIT_V(6); PG8_BAR;
    } else {
        PG8_STAGE(PG8_SB(0, 0), cB, voffB); PG8_STAGE(PG8_SA(0, 0), cA, voffA); PG8_STAGE(PG8_SB(0, 1), cB + hstep, voffB); PG8_STAGE(PG8_SA(0, 1), cA + hstepA, voffA);
        if (wr == 1) PG8_BAR;
        PG8_WAIT_V(4); PG8_BAR;
        PG8_STAGE(PG8_SB(1, 0), cB + kstep, voffB); PG8_STAGE(PG8_SA(1, 0), cA + kstepA, voffA); PG8_STAGE(PG8_SB(1, 1), cB + hstep + kstep, voffB);
        PG8_WAIT_V(6); PG8_BAR;
    }
    for (;;) {
        const bool has_next = S.next(ui + 1, nxt);
        const char* nA = has_next ? (const char*)g.A + (size_t)nxt.pm * tstep + (size_t)(nxt.k0 / BK) * kstepA : cA; const char* nB = has_next ? (const char*)g.Bt + (size_t)nxt.pn * tstep + (size_t)nxt.k0 * 2 : cB;
        const int nt = cur.nt;
        const bool thin = (THIN_PN >= 0) && (cur.pn == THIN_PN);
        for (int t = 0; t < nt; t += 2) {
            const bool last = (t == nt - 2);
            const char* a1 = cA + (size_t)(t + 1) * kstepA;
            const char* a2 = last ? nA : cA + (size_t)(t + 2) * kstepA; const char* b2 = last ? nB : cB + (size_t)(t + 2) * kstep;
            const char* a3 = a2 + kstepA; const char* b3 = b2 + kstep;
            if (last && has_next) S.a_ready(nxt);
            if constexpr (SP2) {
            PG8_LDB(B0, 0, 0); PG8_LDB(B1, 0, 1); PG8_SCHED; PG8_LDA(At, 0, 0); PG8_STAGE(PG8_SA(1, 1), a1 + hstepA, voffA);
            PG8_WAIT_V(8); PG8_WAIT_L(0); PG8_BAR; PG8_MMAT(0, 0, At, B0); PG8_MMAT(0, 1, At, B1); PG8_BAR; PG8_SCHED;
            PG8_LDA(At, 0, 1); PG8_STAGE(PG8_SB(0, 0), b2, voffB); PG8_STAGE(PG8_SB(0, 1), b2 + hstep, voffB); PG8_STAGE(PG8_SA(0, 0), a2, voffA);
            PG8_WAIT_V(8); PG8_WAIT_L(0); PG8_BAR; PG8_MMAT(1, 0, At, B0); PG8_MMAT(1, 1, At, B1); PG8_BAR; PG8_SCHED;
            PG8_LDB(B0, 1, 0); PG8_LDB(B1, 1, 1); PG8_SCHED; PG8_LDA(At, 1, 0); PG8_STAGE(PG8_SA(0, 1), a2 + hstepA, voffA);
            PG8_WAIT_V(8); PG8_WAIT_L(0); PG8_BAR; PG8_MMAT(0, 0, At, B0); PG8_MMAT(0, 1, At, B1); PG8_BAR; PG8_SCHED;
            PG8_LDA(At, 1, 1); PG8_STAGE(PG8_SB(1, 0), b3, voffB); PG8_STAGE(PG8_SB(1, 1), b3 + hstep, voffB); PG8_STAGE(PG8_SA(1, 0), a3, voffA);
            PG8_WAIT_V(8); PG8_WAIT_L(0); PG8_BAR; PG8_MMAT(1, 0, At, B0); PG8_MMAT(1, 1, At, B1); PG8_BAR; PG8_SCHED;
            } else {
            PG8_LDB(B0, 0, 0); PG8_SCHED; PG8_LDA(At, 0, 0); PG8_STAGE(PG8_SA(1, 1), a1 + hstepA, voffA);
            PG8_WAIT_L(8); PG8_BAR; PG8_WAIT_L(0); PG8_MMAT(0, 0, At, B0); PG8_BAR; PG8_SCHED;
            PG8_LDB(B1, 0, 1); PG8_STAGE(PG8_SB(0, 0), b2, voffB);
            PG8_BAR; PG8_WAIT_L(0); PG8_MMAT(0, 1, At, B1); PG8_BAR;
            PG8_LDA(At, 0, 1); PG8_STAGE(PG8_SA(0, 0), a2, voffA);
            PG8_BAR; PG8_WAIT_L(0); PG8_MMAT(1, 0, At, B0); PG8_BAR; PG8_SCHED;
            PG8_STAGE(PG8_SB(0, 1), b2 + hstep, voffB);
            PG8_WAIT_V(6); PG8_BAR; PG8_MMAT(1, 1, At, B1); PG8_BAR;
            PG8_LDB(B0, 1, 0); PG8_SCHED; PG8_LDA(At, 1, 0); PG8_STAGE(PG8_SA(0, 1), a2 + hstepA, voffA);
            PG8_WAIT_L(8); PG8_BAR; PG8_WAIT_L(0); PG8_MMAT(0, 0, At, B0); PG8_BAR; PG8_SCHED;
            PG8_LDB(B1, 1, 1); PG8_STAGE(PG8_SB(1, 0), b3, voffB);
            PG8_BAR; PG8_WAIT_L(0); PG8_MMAT(0, 1, At, B1); PG8_BAR;
            PG8_LDA(At, 1, 1); PG8_STAGE(PG8_SA(1, 0), a3, voffA);
            PG8_BAR; PG8_WAIT_L(0); PG8_MMAT(1, 0, At, B0); PG8_BAR; PG8_SCHED;
            PG8_STAGE(PG8_SB(1, 1), b3 + hstep, voffB);
            PG8_WAIT_V(6); PG8_BAR; PG8_MMAT(1, 1, At, B1); PG8_BAR;
            }
        }
        if constexpr (ALIGN_EPI) { if (wr == 0) PG8_BAR; }
        if constexpr (!Epi::AFTER_DRAIN) { E(acc, cur, wr, wc, fr, fq); S.done(cur); }
        if (!has_next) break;
#pragma unroll
        for (int a = 0; a < 2; ++a)
#pragma unroll
            for (int b = 0; b < 2; ++b)
#pragma unroll
                for (int m = 0; m < 4; ++m)
#pragma unroll
                    for (int n = 0; n < 2; ++n) acc[a][b][m][n] = (f32x4){0.f, 0.f, 0.f, 0.f};
        cur = nxt; cA = nA; cB = nB; ++ui;
        if constexpr (ALIGN_EPI) { if (wr == 1) PG8_BAR; }
    }
    PG8_WAIT_V(0);
    if constexpr (!ALIGN_EPI) { if (wr == 0) PG8_BAR; }
    PG8_BAR;
    if constexpr (Epi::AFTER_DRAIN) { E.fused(acc, cur, wr, wc, fr, fq, lds, wid, lane); S.done(cur); }
#undef PG8_SA
#undef PG8_SB
#undef PG8_STAGE
#undef PG8_LDA
#undef PG8_LDB
#undef PG8_MMA
#undef PG8_MMAT
#undef PG8_WAIT_V
#undef PG8_WAIT_L
#undef PG8_BAR
#undef PG8_SCHED
}
}
#include <hip/hip_bf16.h>
#include <cmath>
namespace attn_body {
using bf16=__hip_bfloat16;
using bf16x8=__attribute__((ext_vector_type(8)))short;
using s16x4=__attribute__((ext_vector_type(4)))short;
using f32x16=__attribute__((ext_vector_type(16)))float;
using u32x4=__attribute__((ext_vector_type(4)))unsigned;
constexpr int D=64,QP=1024,KVP=128;
constexpr int NW=8,QBLK=32,QB=QBLK*NW,KVBLK=64;
__device__ __forceinline__ int crow(int r,int hi){return (r&3)+8*(r>>2)+4*hi;}
#define SBAR() __builtin_amdgcn_sched_barrier(0)
constexpr int NSLOT=3, SLOTB=8192;
constexpr int LDS_K=0, LDS_V=NSLOT*SLOTB, LDS_WS=2*NSLOT*SLOTB, LDS_OST=LDS_WS+NW*64*4, LDS_BYTES=LDS_OST+NW*4096;
constexpr float C2=0.125f*1.4426950408889634f;
__device__ __forceinline__ void glds16(const void*gsrc,unsigned lds_dst){unsigned keep;
  asm volatile("s_mov_b32 %0, m0\n\ts_mov_b32 m0, %2\n\ts_nop 0\n\tglobal_load_lds_dwordx4 %1, off\n\ts_mov_b32 m0, %0":"=&s"(keep):"v"(gsrc),"s"(lds_dst):"memory");}
__device__ __forceinline__ float max3f(float a,float b,float c){float r;asm("v_max3_f32 %0, %1, %2, %3":"=v"(r):"v"(a),"v"(b),"v"(c));return r;}
__device__ __forceinline__ float max2f(float a,float b){float r;asm("v_max_f32_e32 %0, %1, %2":"=v"(r):"v"(a),"v"(b));return r;}
__device__ __forceinline__ float fadd_s(float a,float b){float r;asm("v_add_f32_e32 %0, %1, %2":"=v"(r):"v"(a),"v"(b));return r;}
__device__ __forceinline__ float fsub_s(float a,float b){float r;asm("v_sub_f32_e32 %0, %1, %2":"=v"(r):"v"(a),"v"(b));return r;}
typedef float f32x2_t __attribute__((ext_vector_type(2))); typedef __bf16 bf16x2_t __attribute__((ext_vector_type(2)));
__device__ __forceinline__ unsigned cvtpk_s(float lo,float hi){f32x2_t v={lo,hi};bf16x2_t b=__builtin_convertvector(v,bf16x2_t);return __builtin_bit_cast(unsigned,b);}
#define WAIT_BAR(N) asm volatile("s_waitcnt vmcnt(" #N ") lgkmcnt(0)\n\ts_barrier":::"memory")

__device__ __forceinline__ void qkt(f32x16&p0,f32x16&p1,const char*Kslot,const bf16x8*qr,const f32x16&negm,int r32,int hi){
  const char*kb=Kslot+hi*1024+r32*16;
  #pragma unroll
  for(int d0=0;d0<4;++d0){
    const bf16x8 b0=*reinterpret_cast<const bf16x8*>(kb+d0*2048);
    const bf16x8 b1=*reinterpret_cast<const bf16x8*>(kb+d0*2048+512);
    if(d0==0){p0=__builtin_amdgcn_mfma_f32_32x32x16_bf16(b0,qr[0],negm,0,0,0);p1=__builtin_amdgcn_mfma_f32_32x32x16_bf16(b1,qr[0],negm,0,0,0);}
    else{p0=__builtin_amdgcn_mfma_f32_32x32x16_bf16(b0,qr[d0],p0,0,0,0);p1=__builtin_amdgcn_mfma_f32_32x32x16_bf16(b1,qr[d0],p1,0,0,0);}}
}
typedef __attribute__((address_space(3))) const char* lds_cptr;
typedef short v4i16_t __attribute__((ext_vector_type(4)));
__device__ __forceinline__ void kload8(bf16x8*kf,lds_cptr kp){
  kf[0]=*(const __attribute__((address_space(3))) bf16x8*)(kp);      kf[1]=*(const __attribute__((address_space(3))) bf16x8*)(kp+512);
  kf[2]=*(const __attribute__((address_space(3))) bf16x8*)(kp+2048); kf[3]=*(const __attribute__((address_space(3))) bf16x8*)(kp+2560);
  kf[4]=*(const __attribute__((address_space(3))) bf16x8*)(kp+4096); kf[5]=*(const __attribute__((address_space(3))) bf16x8*)(kp+4608);
  kf[6]=*(const __attribute__((address_space(3))) bf16x8*)(kp+6144); kf[7]=*(const __attribute__((address_space(3))) bf16x8*)(kp+6656);
}
__device__ __forceinline__ void kload2(bf16x8*kf,lds_cptr kp,int j){ kf[2*j]=*(const __attribute__((address_space(3))) bf16x8*)(kp+j*2048); kf[2*j+1]=*(const __attribute__((address_space(3))) bf16x8*)(kp+j*2048+512); }
__device__ __forceinline__ s16x4 vtr(lds_cptr p){ return __builtin_bit_cast(s16x4,__builtin_amdgcn_ds_read_tr16_b64_v4i16((__attribute__((address_space(3))) v4i16_t*)p)); }
__device__ __forceinline__ float rowmax(const f32x16&p0,const f32x16&p1){
  float a=max3f(p0[0],p0[1],p1[0]),b=max3f(p0[2],p0[3],p1[1]);a=max3f(a,p1[2],p1[3]);
  #pragma unroll
  for(int r=4;r<16;r+=4){a=max3f(a,p0[r],p0[r+1]);b=max3f(b,p0[r+2],p0[r+3]);a=max3f(a,p1[r],p1[r+1]);b=max3f(b,p1[r+2],p1[r+3]);}
  const float m=max2f(a,b);
  auto rr=__builtin_amdgcn_permlane32_swap(__float_as_uint(m),__float_as_uint(m),false,false);
  return max2f(__uint_as_float(rr[0]),__uint_as_float(rr[1]));
}
__device__ __forceinline__ void pv(f32x16*o,int vb,bf16x8 pa0,bf16x8 pa1,bf16x8 pa2,bf16x8 pa3){
  #pragma unroll
  for(int d0=0;d0<2;++d0){s16x4 lo[4],hi[4];
    #pragma unroll
    for(int ks=0;ks<4;++ks){
      asm volatile("ds_read_b64_tr_b16 %0,%1 offset:%c2":"=&v"(lo[ks]):"v"(vb),"i"(d0*4096+ks*1024):"memory");
      asm volatile("ds_read_b64_tr_b16 %0,%1 offset:%c2":"=&v"(hi[ks]):"v"(vb),"i"(d0*4096+ks*1024+512):"memory");}
    asm volatile("s_waitcnt lgkmcnt(0)":::"memory");SBAR();
    #define PK(k) (bf16x8){lo[k][0],lo[k][1],lo[k][2],lo[k][3],hi[k][0],hi[k][1],hi[k][2],hi[k][3]}
    o[d0]=__builtin_amdgcn_mfma_f32_32x32x16_bf16(pa0,PK(0),o[d0],0,0,0);
    o[d0]=__builtin_amdgcn_mfma_f32_32x32x16_bf16(pa1,PK(1),o[d0],0,0,0);
    o[d0]=__builtin_amdgcn_mfma_f32_32x32x16_bf16(pa2,PK(2),o[d0],0,0,0);
    o[d0]=__builtin_amdgcn_mfma_f32_32x32x16_bf16(pa3,PK(3),o[d0],0,0,0);
    #undef PK
  }
}

#ifndef ATTN_STORE16
#define ATTN_STORE16(p,v) (*(u32x4*)(p)=(v))
#endif
template<int THRL> __device__ __forceinline__ void attn_unit(bf16*Qu,bf16*Ou,const bf16*__restrict__ Kh,const bf16*__restrict__ Vh,const int NT,char*shm){
  const int tid=opaque_tid(),lane=tid&63,r32=lane&31,hi=lane>>5; const int wid=__builtin_amdgcn_readfirstlane(tid>>6);
  const bf16*Qw=Qu+(long)(wid*QBLK)*QP;
  const unsigned lds0=(unsigned)(uintptr_t)shm;
  float*wsf=(float*)(shm+LDS_WS)+wid*64;
  const bf16*ksrc=Kh+(long)lane*KVP+wid*8;
  const bf16*vsrc=Vh+(long)(16*(wid&3)+(lane>>2))*KVP+(wid>>2)*32+(lane&3)*8;
  const unsigned kdst=lds0+LDS_K+wid*1024, vdst=lds0+LDS_V+wid*1024;
  #define DMA_K(t,slot) glds16(ksrc+(long)(t)*KVBLK*KVP,(unsigned)__builtin_amdgcn_readfirstlane(kdst+(slot)))
  #define DMA_V(t,slot) glds16(vsrc+(long)(t)*KVBLK*KVP,(unsigned)__builtin_amdgcn_readfirstlane(vdst+(slot)))
  const int vb0=(int)(lds0+LDS_V)+((lane>>4)&1)*32+(lane&3)*8+(4*hi+((lane&15)>>2))*64;
  const char*Kbase=shm+LDS_K; bf16x8 kf[8];
  const lds_cptr shm3=(lds_cptr)shm; const lds_cptr kp0=shm3+LDS_K+hi*1024+r32*16; const lds_cptr vp0=shm3+LDS_V+((lane>>4)&1)*32+(lane&3)*8+(4*hi+((lane&15)>>2))*64;
  DMA_K(0,0);DMA_V(0,0);DMA_K(1,SLOTB);
  bf16x8 qr[4];
  #pragma unroll
  for(int d0=0;d0<4;++d0)qr[d0]=*reinterpret_cast<const bf16x8*>(&Qw[(long)r32*QP+d0*16+hi*8]);
  float mhat=0.f,l_reg=0.f;f32x16 o[2];o[0]=f32x16{};o[1]=f32x16{};f32x16 negm=f32x16{};asm volatile("":"+v"(negm));
  #define CMASK(P0,P1,t) do{}while(0)
  bool resc=false;
  #define START(P0,P1) do{ const float rm=rowmax(P0,P1); resc=false; \
    { const float dl=rm; mhat=fadd_s(mhat,dl); \
      _Pragma("unroll") for(int r=0;r<16;++r){P0[r]=fsub_s(P0[r],dl);P1[r]=fsub_s(P1[r],dl);} \
      _Pragma("unroll") for(int r=0;r<16;++r)negm[r]=-mhat; asm volatile("":"+v"(negm)); } \
    _Pragma("unroll") for(int r=0;r<16;++r)P0[r]=__builtin_amdgcn_exp2f(P0[r]); }while(0)
  #define RESC() do{ if(resc){ asm volatile("s_waitcnt lgkmcnt(0)":::"memory"); \
      _Pragma("unroll") for(int d_=0;d_<2;++d_) _Pragma("unroll") for(int r=0;r<16;++r)o[d_][r]*=wsf[crow(r,hi)]; } }while(0)
  f32x16 pA0,pA1,pB0,pB1;
  int sl_prev=0,sl_cur=0,sl_next=SLOTB;
  #define ROT() do{sl_prev=sl_cur;sl_cur=sl_next;sl_next=(sl_next==(NSLOT-1)*SLOTB)?0:sl_next+SLOTB;}while(0)
  DMA_K(2,2*SLOTB);
  WAIT_BAR(3);
  qkt(pA0,pA1,Kbase,qr,negm,r32,hi);asm volatile("s_nop 15\n\ts_nop 7":"+v"(pA0),"+v"(pA1));CMASK(pA0,pA1,0);
  START(pA0,pA1);
  _Pragma("unroll") for(int r=0;r<16;++r)pA1[r]=__builtin_amdgcn_exp2f(pA1[r]);
  WAIT_BAR(0);
  DMA_K(3,0);DMA_V(1,SLOTB);
  ROT();
  kload8(kf,kp0+sl_cur);
  WAIT_BAR(2);
  s16x4 vlo[8],vhi[8]; u32x4 pw0,pw1,pw2,pw3;
  #define PKW(P,B) cvtpk_s(P[B],P[B+1])
  #define PAF(k) __builtin_bit_cast(bf16x8,pw##k)
  #define VFR(i) (bf16x8){vlo[i][0],vlo[i][1],vlo[i][2],vlo[i][3],vhi[i][0],vhi[i][1],vhi[i][2],vhi[i][3]}
  #define PIN(x) asm volatile("":"+v"(x))
  #define MX3(a,b,c) __builtin_fmaxf(__builtin_fmaxf((a),(b)),(c))
  #define GAPA(MF,A0,A1,A2,A3,W0,W1,PW) do{ MF; sacc+=A0; sacc+=A1; sacc+=A2; sacc+=A3; PIN(sacc); W0; W1; PIN(PW); SBAR(); }while(0)
  #define EX(v) __builtin_amdgcn_exp2f(v)
  #define GAPB(MF,X,B) do{ MF; X[B]=EX(X[B]); X[B+1]=EX(X[B+1]); X[B+2]=EX(X[B+2]); X[B+3]=EX(X[B+3]); PIN(X); SBAR(); }while(0)
  #define VRD(i) do{ vlo[i]=vtr(vp_+(((i)>>2)*4096+((i)&3)*1024)); vhi[i]=vtr(vp_+(((i)>>2)*4096+((i)&3)*1024+512)); }while(0)
  #define KRD(G,j) do{ if(G){ kload2(kf,kp0+sl_next,j); SBAR(); } }while(0)
  #define STEP(C0,C1,P0,P1,t,GK,GV,GL) do{ SBAR(); \
    const lds_cptr vp_=vp0+sl_prev; \
    VRD(0); SBAR(); float sacc=(P0[0]+P0[1]); \
    GAPA(C0=__builtin_amdgcn_mfma_f32_32x32x16_bf16(kf[0],qr[0],negm,0,0,0), P0[2],P0[3],P0[4],P0[5],     pw0[0]=PKW(P0,0), pw0[1]=PKW(P0,2), pw0); \
    VRD(4); SBAR(); GAPA(C1=__builtin_amdgcn_mfma_f32_32x32x16_bf16(kf[1],qr[0],negm,0,0,0), P0[6],P0[7],P0[8],P0[9],     pw0[2]=PKW(P0,4), pw0[3]=PKW(P0,6), pw0); \
    VRD(1); SBAR(); GAPA(C0=__builtin_amdgcn_mfma_f32_32x32x16_bf16(kf[2],qr[1],C0,0,0,0),   P0[10],P0[11],P0[12],P0[13], pw1[0]=PKW(P0,8), pw1[1]=PKW(P0,10), pw1); \
    VRD(5); SBAR(); GAPA(C1=__builtin_amdgcn_mfma_f32_32x32x16_bf16(kf[3],qr[1],C1,0,0,0),   P0[14],P0[15],P1[0],P1[1],   pw1[2]=PKW(P0,12),pw1[3]=PKW(P0,14), pw1); \
    VRD(2); SBAR(); GAPA(C0=__builtin_amdgcn_mfma_f32_32x32x16_bf16(kf[4],qr[2],C0,0,0,0),   P1[2],P1[3],P1[4],P1[5],     pw2[0]=PKW(P1,0), pw2[1]=PKW(P1,2), pw2); \
    VRD(6); SBAR(); GAPA(C1=__builtin_amdgcn_mfma_f32_32x32x16_bf16(kf[5],qr[2],C1,0,0,0),   P1[6],P1[7],P1[8],P1[9],     pw2[2]=PKW(P1,4), pw2[3]=PKW(P1,6), pw2); \
    VRD(3); SBAR(); GAPA(C0=__builtin_amdgcn_mfma_f32_32x32x16_bf16(kf[6],qr[3],C0,0,0,0),   P1[10],P1[11],P1[12],P1[13], pw3[0]=PKW(P1,8), pw3[1]=PKW(P1,10), pw3); \
    VRD(7); SBAR(); GAPA(C1=__builtin_amdgcn_mfma_f32_32x32x16_bf16(kf[7],qr[3],C1,0,0,0),   P1[14],P1[15],0.f,0.f,       pw3[2]=PKW(P1,12),pw3[3]=PKW(P1,14), pw3); \
    l_reg+=sacc; \
    if(GK){DMA_K((t)+3,sl_cur);} if(GV){DMA_V((t)+1,sl_next);} \
    CMASK(C0,C1,t); \
    { float a=MX3(C0[0],C0[1],C1[0]),b=MX3(C0[2],C0[3],C1[1]); a=MX3(a,C1[2],C1[3]); \
      _Pragma("unroll") for(int r=4;r<16;r+=4){a=MX3(a,C0[r],C0[r+1]);b=MX3(b,C0[r+2],C0[r+3]);a=MX3(a,C1[r],C1[r+1]);b=MX3(b,C1[r+2],C1[r+3]);} \
      float rm=__builtin_fmaxf(a,b); { auto rr=__builtin_amdgcn_permlane32_swap(__float_as_uint(rm),__float_as_uint(rm),false,false); rm=__builtin_fmaxf(__uint_as_float(rr[0]),__uint_as_float(rr[1])); } \
      resc=false; \
      if(__builtin_expect(__any(rm>(float)THRL),0)){ const float dl=__builtin_fmaxf(rm,0.f); mhat+=dl; \
        _Pragma("unroll") for(int r=0;r<16;++r){C0[r]-=dl;C1[r]-=dl;} \
        _Pragma("unroll") for(int r=0;r<16;++r)negm[r]=-mhat; asm volatile("":"+v"(negm)); \
        const float f=__builtin_amdgcn_exp2f(-dl); l_reg*=f; if(hi==0)wsf[r32]=f; resc=true; } } \
    SBAR(); \
    GAPB(o[0]=__builtin_amdgcn_mfma_f32_32x32x16_bf16(PAF(0),VFR(0),o[0],0,0,0), C0,0); \
    GAPB(o[1]=__builtin_amdgcn_mfma_f32_32x32x16_bf16(PAF(0),VFR(4),o[1],0,0,0), C0,4); \
    KRD(GL,0); GAPB(o[0]=__builtin_amdgcn_mfma_f32_32x32x16_bf16(PAF(1),VFR(1),o[0],0,0,0), C0,8); \
    KRD(GL,1); GAPB(o[1]=__builtin_amdgcn_mfma_f32_32x32x16_bf16(PAF(1),VFR(5),o[1],0,0,0), C0,12); \
    KRD(GL,2); GAPB(o[0]=__builtin_amdgcn_mfma_f32_32x32x16_bf16(PAF(2),VFR(2),o[0],0,0,0), C1,0); \
    KRD(GL,3); GAPB(o[1]=__builtin_amdgcn_mfma_f32_32x32x16_bf16(PAF(2),VFR(6),o[1],0,0,0), C1,4); \
    GAPB(o[0]=__builtin_amdgcn_mfma_f32_32x32x16_bf16(PAF(3),VFR(3),o[0],0,0,0), C1,8); \
    GAPB(o[1]=__builtin_amdgcn_mfma_f32_32x32x16_bf16(PAF(3),VFR(7),o[1],0,0,0), C1,12); \
    }while(0)
  int t=1;
  #undef CMASK
  #define CMASK(P0,P1,t) do{}while(0)
  for(;t+5<NT;t+=2){
    STEP(pB0,pB1,pA0,pA1,t,true,true,true);     WAIT_BAR(2); RESC(); ROT();
    STEP(pA0,pA1,pB0,pB1,t+1,true,true,true);   WAIT_BAR(2); RESC(); ROT();
  }
  #undef CMASK
  #define CMASK(P0,P1,t) do{}while(0)
  #define ENDW(tt) do{ if((tt)+3<NT){WAIT_BAR(2);} else if((tt)+2<NT){WAIT_BAR(1);} else {WAIT_BAR(0);} }while(0)
  for(;t+1<NT;t+=2){
    STEP(pB0,pB1,pA0,pA1,t,(t+3<NT),(t+1<NT),(t+1<NT));       ENDW(t);   RESC(); ROT();
    STEP(pA0,pA1,pB0,pB1,t+1,(t+4<NT),(t+2<NT),(t+2<NT));     ENDW(t+1); RESC(); ROT();
  }
  STEP(pB0,pB1,pA0,pA1,NT-1,false,false,false); RESC();
  { float sacc=pB0[0]+pB0[1]; _Pragma("unroll") for(int r=2;r<16;++r)sacc+=pB0[r]; _Pragma("unroll") for(int r=0;r<16;++r)sacc+=pB1[r]; l_reg+=sacc;
    pw0=(u32x4){PKW(pB0,0),PKW(pB0,2),PKW(pB0,4),PKW(pB0,6)};pw1=(u32x4){PKW(pB0,8),PKW(pB0,10),PKW(pB0,12),PKW(pB0,14)};pw2=(u32x4){PKW(pB1,0),PKW(pB1,2),PKW(pB1,4),PKW(pB1,6)};pw3=(u32x4){PKW(pB1,8),PKW(pB1,10),PKW(pB1,12),PKW(pB1,14)};
    SBAR(); pv(o,vb0+sl_cur,PAF(0),PAF(1),PAF(2),PAF(3)); }
  #undef PKW
  #undef PAF
  #undef VFR
  #undef PIN
  #undef MX3
  #undef GAPA
  #undef GAPB
  #undef EX
  #undef VRD
  #undef KRD
  #undef STEP
  #undef ENDW
  {auto rr=__builtin_amdgcn_permlane32_swap(__float_as_uint(l_reg),__float_as_uint(l_reg),false,false);l_reg=__uint_as_float(rr[0])+__uint_as_float(rr[1]);}
  if(hi==0)wsf[32+r32]=l_reg;asm volatile("s_waitcnt lgkmcnt(0)":::"memory");
  float rli[16];
  #pragma unroll
  for(int r=0;r<16;++r)rli[r]=__builtin_amdgcn_rcpf(wsf[32+crow(r,hi)]);
  bf16*Ow=Ou+(long)(wid*QBLK)*QP;
  { bf16*stg=(bf16*)(shm+LDS_OST)+wid*2048;
    #pragma unroll
    for(int r=0;r<16;++r){const int orow=crow(r,hi);
      #pragma unroll
      for(int d0=0;d0<2;++d0)stg[orow*64+d0*32+r32]=__float2bfloat16(o[d0][r]*rli[r]);}
    asm volatile("s_waitcnt lgkmcnt(0)":::"memory");
    #pragma unroll
    for(int i=0;i<4;++i){const int row=i*8+(lane>>3),ch=lane&7; const u32x4 v=*(const u32x4*)(stg+row*64+ch*8); ATTN_STORE16(Ow+(long)row*QP+ch*8,v);} }
  asm volatile("s_waitcnt lgkmcnt(0)\n\ts_barrier":::"memory");
  #undef DMA_K
  #undef DMA_V
  #undef CMASK
  #undef START
  #undef RESC
  #undef ROT
}
constexpr int ATTN_LDS_BYTES=LDS_BYTES;
#undef SBAR
#undef WAIT_BAR
}
#define LAS __attribute__((address_space(3)))
typedef unsigned short bf16;
typedef unsigned v4u __attribute__((ext_vector_type(4)));
typedef unsigned v2u __attribute__((ext_vector_type(2)));
typedef float f32x4 __attribute__((ext_vector_type(4)));
typedef short bf16x8 __attribute__((ext_vector_type(8)));
typedef short bf16x4 __attribute__((ext_vector_type(4)));

constexpr int NB = 8, TL = 4096, TCX = 256, DM = 1024, DEPTH = 4, NMOD = 6;
constexpr int ML = NB * TL, MC = NB * TCX, MT = ML + MC;
constexpr int NINP = 3072, NIN = 2832;
constexpr int FF = 4096, KVLEN = TCX + TL;
constexpr float EPS = 1e-6f;
constexpr size_t MiB = 1u << 20;
constexpr size_t WS_MOD = 64 * 1024;
constexpr size_t WS_WIN = 2 * MiB, WS_WOUT = 8 * MiB, WS_W1 = 10 * MiB, WS_W2 = 18 * MiB;
constexpr size_t WS_X = 26 * MiB;
constexpr size_t WS_XN = 162 * MiB;
constexpr size_t WS_HB = WS_XN + 34 * MiB;
constexpr size_t WS_AO = 230 * MiB;
constexpr size_t WS_PM = 298 * MiB;
constexpr size_t WS_K = 434 * MiB, WS_V = 443 * MiB;
constexpr size_t WS_G = 452 * MiB;
constexpr size_t WS_H = 230 * MiB;
constexpr size_t WS_GA = 456 * MiB, WS_BP = 458 * MiB, WS_CH = 462 * MiB;
constexpr size_t WS_END = 502 * MiB;
constexpr int LDS_BYTES = 163840, TAB_OFF = 163840 - 256;
__device__ __forceinline__ unsigned long long rd_ptr(const unsigned char* lds, int k) {
    const LAS unsigned* t = (const LAS unsigned*)((const LAS unsigned char*)lds + TAB_OFF) + 2 * k; unsigned lo = t[0], hi = t[1];
    lo = __builtin_amdgcn_readfirstlane(lo); hi = __builtin_amdgcn_readfirstlane(hi); return ((unsigned long long)hi << 32) | lo; }

__device__ __forceinline__ unsigned f2bf(float f) { unsigned u = __builtin_bit_cast(unsigned, f); return (u + 0x7fffu + ((u >> 16) & 1u)) >> 16; }
__device__ __forceinline__ unsigned pk2(float lo, float hi) { return pg8::cvt_pk_bf16(lo, hi); }
__device__ __forceinline__ float bflo(unsigned w) { return __builtin_bit_cast(float, w << 16); }
__device__ __forceinline__ float bfhi(unsigned w) { return __builtin_bit_cast(float, w & 0xffff0000u); }
__device__ __forceinline__ float wave_sum(float v) {
#pragma unroll
    for (int o = 1; o < 64; o <<= 1) v += __shfl_xor(v, o);
    return v;
}
__device__ __forceinline__ float sigmoidf_(float x) { return 1.f / (1.f + __expf(-x)); }
__device__ __forceinline__ float siluf_(float x) { return x / (1.f + __expf(-x)); }
__device__ __forceinline__ float logsigmoidf_(float x) { return x < 0.f ? x - log1pf(__expf(x)) : -log1pf(__expf(-x)); }

struct Args { const float* in[18]; float* out; unsigned char* ws; };

__device__ __forceinline__ void transpose_item(const float* W, int K, int N, int NBLK, bf16* WT, float* scr, int item, int lane) {
    const int kb = item / NBLK, nb = item % NBLK, k0 = 64 * kb, n0 = 32 * nb; const int n = n0 + (lane & 31);
#pragma unroll 16
    for (int i = 0; i < 32; ++i) { const int kk = 2 * i + (lane >> 5); scr[kk * 33 + (lane & 31)] = (n < N) ? W[(size_t)(k0 + kk) * N + n] : 0.f; }
    asm volatile("s_waitcnt lgkmcnt(0)" ::: "memory");
    const int c = lane & 7;
#pragma unroll
    for (int j = 0; j < 4; ++j) { const int nn = (lane >> 3) + 8 * j; const float* s = scr + (8 * c) * 33 + nn;
        v4u o; o.x = pk2(s[0 * 33], s[1 * 33]); o.y = pk2(s[2 * 33], s[3 * 33]); o.z = pk2(s[4 * 33], s[5 * 33]); o.w = pk2(s[6 * 33], s[7 * 33]);
        *(v4u*)(WT + (size_t)(n0 + nn) * K + k0 + 8 * c) = o; }
    asm volatile("s_waitcnt lgkmcnt(0)" ::: "memory");
}

template <bool BF> __device__ __forceinline__ f32x4 ldx4(const void* row, int i) {
    if (BF) { const v2u w = ((const v2u*)row)[i]; return (f32x4){bflo(w.x), bfhi(w.x), bflo(w.y), bfhi(w.y)}; }
    else return ((const f32x4*)row)[i];
}
template <bool BF> __device__ __forceinline__ void modulate_row(const void* xrow, bf16* orow, const float* gain, const float* shift, const float* scale, int lane) {
    f32x4 v[4]; float s = 0.f;
#pragma unroll
    for (int j = 0; j < 4; ++j) { v[j] = ldx4<BF>(xrow, lane + 64 * j); s += (v[j].x * v[j].x + v[j].y * v[j].y) + (v[j].z * v[j].z + v[j].w * v[j].w); }
    const float r = rsqrtf(wave_sum(s) * (1.f / DM) + EPS);
    unsigned long long* o8 = (unsigned long long*)orow + lane;
#pragma unroll
    for (int j = 0; j < 4; ++j) { const int c = 4 * lane + 256 * j;
        const f32x4 g = *(const f32x4*)(gain + c), sh = *(const f32x4*)(shift + c), sc = *(const f32x4*)(scale + c);
        const f32x4 y = v[j] * r * g * (sc + 1.f) + sh;
        o8[64 * j] = (unsigned long long)pk2(y.x, y.y) | ((unsigned long long)pk2(y.z, y.w) << 32); }
}
template <bool BF> __device__ __forceinline__ void modulate_row2(const void* x0, bf16* o0, const float* sh0, const float* sc0, const void* x1, bf16* o1, const float* sh1, const float* sc1, const float* gain, int lane) {
    f32x4 v0[4], v1[4]; float s0 = 0.f, s1 = 0.f;
#pragma unroll
    for (int j = 0; j < 4; ++j) { v0[j] = ldx4<BF>(x0, lane + 64 * j); v1[j] = ldx4<BF>(x1, lane + 64 * j); }
#pragma unroll
    for (int j = 0; j < 4; ++j) { s0 += (v0[j].x * v0[j].x + v0[j].y * v0[j].y) + (v0[j].z * v0[j].z + v0[j].w * v0[j].w); s1 += (v1[j].x * v1[j].x + v1[j].y * v1[j].y) + (v1[j].z * v1[j].z + v1[j].w * v1[j].w); }
#pragma unroll
    for (int o = 1; o < 64; o <<= 1) { s0 += __shfl_xor(s0, o); s1 += __shfl_xor(s1, o); }
    const float r0 = rsqrtf(s0 * (1.f / DM) + EPS), r1 = rsqrtf(s1 * (1.f / DM) + EPS);
    unsigned long long* p0 = (unsigned long long*)o0 + lane; unsigned long long* p1 = (unsigned long long*)o1 + lane;
#pragma unroll
    for (int j = 0; j < 4; ++j) { const int c = 4 * lane + 256 * j;
        const f32x4 g = *(const f32x4*)(gain + c);
        const f32x4 y0 = v0[j] * r0 * g * (*(const f32x4*)(sc0 + c) + 1.f) + *(const f32x4*)(sh0 + c);
        const f32x4 y1 = v1[j] * r1 * g * (*(const f32x4*)(sc1 + c) + 1.f) + *(const f32x4*)(sh1 + c);
        p0[64 * j] = (unsigned long long)pk2(y0.x, y0.y) | ((unsigned long long)pk2(y0.z, y0.w) << 32);
        p1[64 * j] = (unsigned long long)pk2(y1.x, y1.y) | ((unsigned long long)pk2(y1.z, y1.w) << 32); }
}
template <bool BF, int NR> __device__ __forceinline__ void modulate_rowsN(const void* xbase, bf16* obase, int row, int st, const float* modbase  , int shoff, int scoff, const float* gain, int lane) {
    f32x4 v[NR][4]; float ss[NR];
#pragma unroll
    for (int q = 0; q < NR; ++q) { const void* xr = BF ? (const void*)((const bf16*)xbase + (size_t)(row + q * st) * 1024) : (const void*)((const float*)xbase + (size_t)(row + q * st) * 1024);
#pragma unroll
        for (int j = 0; j < 4; ++j) v[q][j] = ldx4<BF>(xr, lane + 64 * j); }
#pragma unroll
    for (int q = 0; q < NR; ++q) { float a = 0.f;
#pragma unroll
        for (int j = 0; j < 4; ++j) a += (v[q][j].x * v[q][j].x + v[q][j].y * v[q][j].y) + (v[q][j].z * v[q][j].z + v[q][j].w * v[q][j].w);
        ss[q] = a; }
#pragma unroll
    for (int o = 1; o < 64; o <<= 1) {
#pragma unroll
        for (int q = 0; q < NR; ++q) ss[q] += __shfl_xor(ss[q], o); }
#pragma unroll
    for (int q = 0; q < NR; ++q) { const int r_ = row + q * st; const float r = rsqrtf(ss[q] * (1.f / DM) + EPS);
        const float* mp = modbase + (size_t)(r_ >> 12) * 6144;
        unsigned long long* p = (unsigned long long*)(obase + (size_t)r_ * 1024) + lane;
#pragma unroll
        for (int j = 0; j < 4; ++j) { const int c = 4 * lane + 256 * j;
            const f32x4 y = v[q][j] * r * *(const f32x4*)(gain + c) * (*(const f32x4*)(mp + scoff + c) + 1.f) + *(const f32x4*)(mp + shoff + c);
            p[64 * j] = (unsigned long long)pk2(y.x, y.y) | ((unsigned long long)pk2(y.z, y.w) << 32); } }
}
template <bool BF> __device__ __forceinline__ void modulate_row_part(const void* xrow, bf16* xout, const bf16* part  , const float* gate, bf16* orow, const float* gain, const float* shift, const float* scale, int lane) {
    f32x4 v[4]; float s = 0.f;
#pragma unroll
    for (int j = 0; j < 4; ++j) { f32x4 p = (f32x4){0.f, 0.f, 0.f, 0.f};
#pragma unroll
        for (int sl = 0; sl < 8; ++sl) p += ldx4<true>(part + (size_t)sl * 2048 * 1024, lane + 64 * j);
        v[j] = ldx4<BF>(xrow, lane + 64 * j) + *(const f32x4*)(gate + 4 * lane + 256 * j) * p;
        ((unsigned long long*)xout + lane)[64 * j] = (unsigned long long)pk2(v[j].x, v[j].y) | ((unsigned long long)pk2(v[j].z, v[j].w) << 32);
        s += (v[j].x * v[j].x + v[j].y * v[j].y) + (v[j].z * v[j].z + v[j].w * v[j].w); }
    const float r = rsqrtf(wave_sum(s) * (1.f / DM) + EPS);
    unsigned long long* o8 = (unsigned long long*)orow + lane;
#pragma unroll
    for (int j = 0; j < 4; ++j) { const int c = 4 * lane + 256 * j;
        const f32x4 g = *(const f32x4*)(gain + c), sh = *(const f32x4*)(shift + c), sc = *(const f32x4*)(scale + c);
        const f32x4 y = v[j] * r * g * (sc + 1.f) + sh;
        o8[64 * j] = (unsigned long long)pk2(y.x, y.y) | ((unsigned long long)pk2(y.z, y.w) << 32); }
}

#define XB_TMO      128
#define XB_XCNT(j)  (256  + 64 * (j))
#define XB_XSUB(j)  (1280 + 64 * (j))
#define XB_XGEN(j)  (2304 + 64 * (j))
#define XB_TOP      3328
#define XB_TOPGEN   3392
#define XCD_BAR_WORDS 3456
#define XB_SPIN_CAP (1u << 18)

__device__ __forceinline__ unsigned xb_ld(unsigned* p)              { return __hip_atomic_load(p, __ATOMIC_RELAXED, __HIP_MEMORY_SCOPE_AGENT); }
__device__ __forceinline__ unsigned xb_add(unsigned* p, unsigned v) { return __hip_atomic_fetch_add(p, v, __ATOMIC_RELAXED, __HIP_MEMORY_SCOPE_AGENT); }
__device__ __forceinline__ unsigned xb_xcc_id() { return (unsigned)__builtin_amdgcn_s_getreg((3 << 11) | 20) & 0xFu; }
#define XB_SPIN(cond, bar) do { unsigned _sp = 0; while (cond) { __builtin_amdgcn_s_sleep(1); \
    if ((++_sp & 255u) == 0u) { if (xb_ld(&(bar)[XB_TMO])) break; if (_sp > XB_SPIN_CAP) { atomicAdd(&(bar)[XB_TMO], 1u); break; } } } } while (0)

struct XcdBarrier {
    unsigned* bar; unsigned x;
    volatile LAS unsigned* st;
};

__device__ __forceinline__ XcdBarrier xcd_barrier_post(unsigned* bar, volatile LAS unsigned* st) {
    XcdBarrier b; b.bar = bar; b.x = xb_xcc_id(); b.st = st;
    if (threadIdx.x == 0) (void)xb_add(&bar[XB_XCNT(b.x)], 1u);
    return b;
}
__device__ __forceinline__ void xcd_barrier_complete(unsigned* bar, unsigned x, unsigned& nloc, unsigned& nx) {
    const unsigned G = gridDim.x * gridDim.y * gridDim.z;
    unsigned sum, cnt, mine, sp = 0u;
    for (;;) {
        sum = 0u; cnt = 0u; mine = 0u;
#pragma unroll
        for (unsigned j = 0; j < 16; ++j) { const unsigned c = xb_ld(&bar[XB_XCNT(j)]); sum += c; cnt += (c > 0u) ? 1u : 0u; mine = (j == x) ? c : mine; }
        if (sum == G) break;
        __builtin_amdgcn_s_sleep(1);
        if ((++sp & 255u) == 0u) { if (xb_ld(&bar[XB_TMO])) break; if (sp > XB_SPIN_CAP) { atomicAdd(&bar[XB_TMO], 1u); break; } }
    }
    nloc = mine > 0u ? mine : 1u; nx = cnt > 0u ? cnt : 1u;
}

__device__ __forceinline__ void xcd_barrier(const XcdBarrier& b) {
    asm volatile("s_waitcnt vmcnt(0)" ::: "memory");
    __syncthreads();
    if (threadIdx.x == 0) {
        unsigned* bar = b.bar;
        __builtin_amdgcn_s_waitcnt(0);
        unsigned nloc = b.st[0], nx = b.st[1];
        if (nloc == 0u) { xcd_barrier_complete(bar, b.x, nloc, nx); b.st[0] = nloc; b.st[1] = nx; }
        const unsigned old = xb_add(&bar[XB_XSUB(b.x)], 1u);
        const unsigned gen = old / nloc;
        if (old + 1u == (gen + 1u) * nloc) {
            __builtin_amdgcn_fence(__ATOMIC_RELEASE, "agent");
            asm volatile("s_waitcnt vmcnt(0)" ::: "memory");
            const unsigned og = xb_add(&bar[XB_TOP], 1u);
            const unsigned tg = og / nx;
            if (og + 1u == (tg + 1u) * nx) xb_add(&bar[XB_TOPGEN], 1u);
            else XB_SPIN(xb_ld(&bar[XB_TOPGEN]) == tg, bar);
            __builtin_amdgcn_fence(__ATOMIC_ACQUIRE, "agent");
            xb_add(&bar[XB_XGEN(b.x)], 1u);
            asm volatile("s_waitcnt vmcnt(0)" ::: "memory");
        } else {
            XB_SPIN(xb_ld(&bar[XB_XGEN(b.x)]) == gen, bar);
            __builtin_amdgcn_fence(__ATOMIC_ACQUIRE, "agent");
            asm volatile("s_waitcnt vmcnt(0)" ::: "memory");
        }
    }
    __syncthreads();
}
__device__ __forceinline__ void modulate_row2(const float* x0, bf16* o0, const float* sh0, const float* sc0, const float* x1, bf16* o1, const float* sh1, const float* sc1, const float* gain, int lane) {
    const f32x4* xr0 = (const f32x4*)x0 + lane; const f32x4* xr1 = (const f32x4*)x1 + lane;
    f32x4 v0[4], v1[4]; float s0 = 0.f, s1 = 0.f;
#pragma unroll
    for (int j = 0; j < 4; ++j) { v0[j] = xr0[64 * j]; v1[j] = xr1[64 * j]; }
#pragma unroll
    for (int j = 0; j < 4; ++j) { s0 += (v0[j].x * v0[j].x + v0[j].y * v0[j].y) + (v0[j].z * v0[j].z + v0[j].w * v0[j].w); s1 += (v1[j].x * v1[j].x + v1[j].y * v1[j].y) + (v1[j].z * v1[j].z + v1[j].w * v1[j].w); }
#pragma unroll
    for (int o = 1; o < 64; o <<= 1) { s0 += __shfl_xor(s0, o); s1 += __shfl_xor(s1, o); }
    const float r0 = rsqrtf(s0 * (1.f / DM) + EPS), r1 = rsqrtf(s1 * (1.f / DM) + EPS);
    unsigned long long* p0 = (unsigned long long*)o0 + lane; unsigned long long* p1 = (unsigned long long*)o1 + lane;
#pragma unroll
    for (int j = 0; j < 4; ++j) { const int c = 4 * lane + 256 * j;
        const f32x4 g = *(const f32x4*)(gain + c);
        const f32x4 y0 = v0[j] * r0 * g * (*(const f32x4*)(sc0 + c) + 1.f) + *(const f32x4*)(sh0 + c);
        const f32x4 y1 = v1[j] * r1 * g * (*(const f32x4*)(sc1 + c) + 1.f) + *(const f32x4*)(sh1 + c);
        p0[64 * j] = (unsigned long long)pk2(y0.x, y0.y) | ((unsigned long long)pk2(y0.z, y0.w) << 32);
        p1[64 * j] = (unsigned long long)pk2(y1.x, y1.y) | ((unsigned long long)pk2(y1.z, y1.w) << 32); }
}
__device__ __forceinline__ void modulate_row_part(const float* xrow, float* xout, const float* part  , const float* gate, bf16* orow, const float* gain, const float* shift, const float* scale, int lane) {
    const f32x4* xr = (const f32x4*)xrow + lane;
    f32x4 v[4]; float s = 0.f;
#pragma unroll
    for (int j = 0; j < 4; ++j) { f32x4 p = (f32x4){0.f, 0.f, 0.f, 0.f};
#pragma unroll
        for (int sl = 0; sl < 8; ++sl) p += *((const f32x4*)(part + (size_t)sl * 2048 * 1024) + lane + 64 * j);
        v[j] = xr[64 * j] + *(const f32x4*)(gate + 4 * lane + 256 * j) * p;
        ((f32x4*)xout + lane)[64 * j] = v[j];
        s += (v[j].x * v[j].x + v[j].y * v[j].y) + (v[j].z * v[j].z + v[j].w * v[j].w); }
    const float r = rsqrtf(wave_sum(s) * (1.f / DM) + EPS);
    unsigned long long* o8 = (unsigned long long*)orow + lane;
#pragma unroll
    for (int j = 0; j < 4; ++j) { const int c = 4 * lane + 256 * j;
        const f32x4 g = *(const f32x4*)(gain + c), sh = *(const f32x4*)(shift + c), sc = *(const f32x4*)(scale + c);
        const f32x4 y = v[j] * r * g * (sc + 1.f) + sh;
        o8[64 * j] = (unsigned long long)pk2(y.x, y.y) | ((unsigned long long)pk2(y.z, y.w) << 32); }
}

constexpr int RS = 136;
constexpr int DVS = 64, NMT = DVS / 16;
constexpr int ML_QS = 0, ML_KS = 128 * RS * 2, ML_KT = 2 * 128 * RS * 2, ML_VT = 3 * 128 * RS * 2, ML_CS = ML_VT + DVS * RS * 2, ML_AV = ML_CS + (DVS + 16) * RS * 2, ML_END = ML_AV + 8 * 128 * 4;
static_assert(ML_END <= TAB_OFF, "mLSTM LDS");
#define MFMA16(a, b, c) __builtin_amdgcn_mfma_f32_16x16x32_bf16((a), (b), (c), 0, 0, 0)

__device__ __forceinline__ void mlstm_item(int item, const bf16* PM  , const float* GA, const float* BP, const float* CH, bf16* HF, bf16* HB, char* lds) {
    const int tid = opaque_tid(), lane = tid & 63, wv = tid >> 6, w = __builtin_amdgcn_readfirstlane(tid >> 6);
    const int chain = item >> 1, slice = item & 1, b = chain >> 3, h = (chain >> 1) & 3, dir = chain & 1;
    const int c16 = lane & 15, quad = lane >> 4;
    bf16* QS = (bf16*)(lds + ML_QS); bf16* KS = (bf16*)(lds + ML_KS); bf16* KT = (bf16*)(lds + ML_KT); bf16* VT = (bf16*)(lds + ML_VT); bf16* CS = (bf16*)(lds + ML_CS);
    float* AV = (float*)(lds + ML_AV) + wv * 128;
    bf16* Hout = dir ? HB : HF;
    const int ttv = (wv < 4) ? wv : 11 - wv, tt = __builtin_amdgcn_readfirstlane(ttv);
    const bf16* qs_f = QS + (16 * ttv + c16) * RS + 8 * quad;
    const bf16* cs_f = CS + c16 * RS + 8 * quad;
    const bf16* ks_f = KS + c16 * RS + 8 * quad;
    const bf16* vt4_f = VT + c16 * RS + 4 * quad;
    const bf16* vt8_f = VT + c16 * RS + 8 * quad;
    const bf16* kt_f = KT + (16 * wv + c16) * RS + 8 * quad;
    bf16* qs_w = QS + (2 * lane) * RS + 16 * wv;
    bf16* ks_w = KS + (2 * lane) * RS + 16 * wv;
    bf16* kt_w = KT + (16 * wv) * RS + 2 * lane;
    bf16* vt_w = VT + (8 * wv) * RS + 2 * lane;
    bf16* cs_w = CS + (4 * quad) * RS + 16 * wv + c16;
    const float* av_r = AV + 4 * quad;
    const int tl = 16 * ttv + c16;
    const float2* ga = (const float2*)(GA + (size_t)chain * KVLEN);
    const float2* bp = (const float2*)BP + (size_t)chain * KVLEN;
    const float2* ch = (const float2*)CH + chain * 34;
    for (int i = tid; i < (DVS + 16) * RS / 2; i += 512) ((unsigned*)CS)[i] = 0u;
    f32x4 Cacc[NMT + 1];
#pragma unroll
    for (int mt = 0; mt <= NMT; ++mt) Cacc[mt] = (f32x4){0.f, 0.f, 0.f, 0.f};
    float m_state = 0.f;
    const bf16x8 ones8 = (c16 == 0) ? (bf16x8){0x3F80, 0x3F80, 0x3F80, 0x3F80, 0x3F80, 0x3F80, 0x3F80, 0x3F80} : (bf16x8){0, 0, 0, 0, 0, 0, 0, 0};
    v4u rq[4], rk[4], rv0, rv1; float2 ra, rbp, rch;
#define ML_LOAD(CI) do { const int ci_ = (CI); const bool ic_ = ci_ < 2; const int cc_ = ic_ ? ci_ : ci_ - 2; const int len_ = ic_ ? TCX : TL; const int rb_ = ic_ ? ML + b * TCX : b * TL; \
        const int i0_ = 128 * cc_ + 2 * lane; const int t0_ = dir ? len_ - 1 - i0_ : i0_; const int t1_ = dir ? t0_ - 1 : t0_ + 1; \
        const bf16* p0_ = PM + (size_t)(rb_ + t0_) * 2048 + h * 128 + 16 * wv; const bf16* p1_ = PM + (size_t)(rb_ + t1_) * 2048 + h * 128 + 16 * wv; \
        rq[0] = *(const v4u*)p0_; rq[1] = *(const v4u*)(p0_ + 8); rq[2] = *(const v4u*)p1_; rq[3] = *(const v4u*)(p1_ + 8); \
        rk[0] = *(const v4u*)(p0_ + 512); rk[1] = *(const v4u*)(p0_ + 520); rk[2] = *(const v4u*)(p1_ + 512); rk[3] = *(const v4u*)(p1_ + 520); \
        rv0 = *(const v4u*)(PM + (size_t)(rb_ + t0_) * 2048 + 1024 + h * 128 + slice * DVS + 8 * wv); rv1 = *(const v4u*)(PM + (size_t)(rb_ + t1_) * 2048 + 1024 + h * 128 + slice * DVS + 8 * wv); \
        ra = ga[64 * ci_ + lane]; rbp = bp[128 * ci_ + tl]; rch = ch[ci_]; } while (0)
    ML_LOAD(0);
    __syncthreads();
    for (int ci = 0; ci < 34; ++ci) {
        const bool isctx = ci < 2; const int cc = isctx ? ci : ci - 2; const int len = isctx ? TCX : TL; const int rowbase = isctx ? ML + b * TCX : b * TL;
        const float a0 = ra.x, a1 = ra.y, b_last = rch.x, amax = rch.y, bt = rbp.x, pmt = rbp.y;
        const float m_new = fmaxf(b_last + m_state, b_last + amax);
        const float decay = __expf(b_last + m_state - m_new);
        const float w0 = __expf(a0 + b_last - m_new), w1 = __expf(a1 + b_last - m_new);
        const float m_t = bt + fmaxf(m_state, pmt);
        const float w_inter = __expf(bt + m_state - m_t);
        const float dbase = bt - m_t;
        ((float2*)AV)[lane] = make_float2(a0, a1);
        *(v4u*)(qs_w) = rq[0]; *(v4u*)(qs_w + 8) = rq[1]; *(v4u*)(qs_w + RS) = rq[2]; *(v4u*)(qs_w + RS + 8) = rq[3];
        *(v4u*)(ks_w) = rk[0]; *(v4u*)(ks_w + 8) = rk[1]; *(v4u*)(ks_w + RS) = rk[2]; *(v4u*)(ks_w + RS + 8) = rk[3];
#pragma unroll
        for (int half = 0; half < 2; ++half)
#pragma unroll
            for (int e = 0; e < 4; ++e) { const unsigned k0w = rk[half][e], k1w = rk[2 + half][e];
                *(unsigned*)(kt_w + (8 * half + 2 * e) * RS) = pk2(bflo(k0w) * w0, bflo(k1w) * w1);
                *(unsigned*)(kt_w + (8 * half + 2 * e + 1) * RS) = pk2(bfhi(k0w) * w0, bfhi(k1w) * w1); }
#pragma unroll
        for (int e = 0; e < 4; ++e) { *(unsigned*)(vt_w + (2 * e) * RS) = (rv0[e] & 0xffffu) | (rv1[e] << 16); *(unsigned*)(vt_w + (2 * e + 1) * RS) = (rv0[e] >> 16) | (rv1[e] & 0xffff0000u); }
        if (ci + 1 < 34) ML_LOAD(ci + 1);
        __syncthreads();
        int tlo_ = tl; asm volatile("" : "+v"(tlo_));
        bf16x8 qf[4];
#pragma unroll
        for (int kk = 0; kk < 4; ++kk) qf[kk] = *(const bf16x8*)(qs_f + 32 * kk);
        f32x4 ao[NMT + 1];
#pragma unroll
        for (int mt = 0; mt <= NMT; ++mt) { ao[mt] = (f32x4){0.f, 0.f, 0.f, 0.f};
#pragma unroll
            for (int kk = 0; kk < 4; ++kk) { const bf16x8 a = *(const bf16x8*)(cs_f + 16 * mt * RS + 32 * kk); ao[mt] = MFMA16(a, qf[kk], ao[mt]); }
            ao[mt] = ao[mt] * w_inter; }
#pragma unroll
        for (int jj = 0; jj < 4; ++jj) {
            if (2 * jj <= tt) {
                f32x4 sv[2];
#pragma unroll
                for (int u = 0; u < 2; ++u) { const int st = 2 * jj + u; sv[u] = (f32x4){0.f, 0.f, 0.f, 0.f};
                    if (st <= tt) {
#pragma unroll
                        for (int kk = 0; kk < 4; ++kk) { const bf16x8 a = *(const bf16x8*)(ks_f + 16 * st * RS + 32 * kk); sv[u] = MFMA16(a, qf[kk], sv[u]); }
                        const f32x4 av = *(const f32x4*)(av_r + 16 * st);
#pragma unroll
                        for (int j = 0; j < 4; ++j) { const int s = 16 * st + 4 * quad + j; const float p = sv[u][j] * __expf(dbase + av[j]); sv[u][j] = (s <= tlo_) ? p : 0.f; }
                    } }
                bf16x8 pb; { v4u t; t.x = pk2(sv[0][0], sv[0][1]); t.y = pk2(sv[0][2], sv[0][3]); t.z = pk2(sv[1][0], sv[1][1]); t.w = pk2(sv[1][2], sv[1][3]); pb = __builtin_bit_cast(bf16x8, t); }
#pragma unroll
                for (int mt = 0; mt < NMT; ++mt) {
                    const bf16x4 lo = *(const bf16x4*)(vt4_f + 16 * mt * RS + 32 * jj), hi = *(const bf16x4*)(vt4_f + 16 * mt * RS + 32 * jj + 16);
                    const bf16x8 a = __builtin_shufflevector(lo, hi, 0, 1, 2, 3, 4, 5, 6, 7);
                    ao[mt] = MFMA16(a, pb, ao[mt]); }
                ao[NMT] = MFMA16(ones8, pb, ao[NMT]);
            }
        }
        {
            const float den = __shfl(ao[NMT][0], c16);
            const float inv = __builtin_amdgcn_rcpf(fmaxf(fabsf(den), __expf(-m_t)));
            const int tokt = dir ? len - 1 - (128 * cc + tl) : 128 * cc + tl;
            bf16* hp = Hout + (size_t)(rowbase + tokt) * 512 + h * 128 + slice * DVS + 4 * quad;
#pragma unroll
            for (int mt = 0; mt < NMT; ++mt) { v2u o; o.x = pk2(ao[mt][0] * inv, ao[mt][1] * inv); o.y = pk2(ao[mt][2] * inv, ao[mt][3] * inv); *(v2u*)(hp + 16 * mt) = o; }
        }
#pragma unroll
        for (int mt = 0; mt <= NMT; ++mt) { Cacc[mt] = Cacc[mt] * decay;
#pragma unroll
            for (int kk = 0; kk < 4; ++kk) {
                const bf16x8 bk = *(const bf16x8*)(kt_f + 32 * kk);
                const bf16x8 a = (mt < NMT) ? *(const bf16x8*)(vt8_f + 16 * mt * RS + 32 * kk) : ones8;
                Cacc[mt] = MFMA16(a, bk, Cacc[mt]); } }
        m_state = m_new;
        __syncthreads();
#pragma unroll
        for (int mt = 0; mt <= NMT; ++mt)
#pragma unroll
            for (int j = 0; j < 4; ++j) cs_w[(16 * mt + j) * RS] = (bf16)f2bf(Cacc[mt][j]);
    }
#undef ML_LOAD
    __syncthreads();
}
__global__ void __launch_bounds__(512, 2) hybrid_fwd(Args args) {
    extern __shared__ __attribute__((aligned(16))) unsigned char lds[];
    cg::grid_group grid = cg::this_grid();
    const int tid = threadIdx.x, lane = tid & 63, wave = __builtin_amdgcn_readfirstlane(tid >> 6);
    const int G = gridDim.x; const int bx = blockIdx.x;
    const int vcu = (G % 8 == 0) ? (bx % 8) * (G / 8) + bx / 8 : bx;
    const int gw = vcu * 8 + wave, NGW = G * 8;
    if (tid == 0) {
        LAS unsigned long long* tab = (LAS unsigned long long*)((LAS unsigned char*)lds + TAB_OFF);
        tab[0] = (unsigned long long)args.in[0]; tab[1] = (unsigned long long)args.in[1]; tab[2] = (unsigned long long)args.in[2]; tab[3] = (unsigned long long)args.in[3];
        tab[4] = (unsigned long long)args.in[4]; tab[5] = (unsigned long long)args.in[5]; tab[6] = (unsigned long long)args.in[6]; tab[7] = (unsigned long long)args.in[7];
        tab[8] = (unsigned long long)args.in[8]; tab[9] = (unsigned long long)args.in[9]; tab[10] = (unsigned long long)args.in[10]; tab[11] = (unsigned long long)args.in[11];
        tab[12] = (unsigned long long)args.in[12]; tab[13] = (unsigned long long)args.in[13]; tab[14] = (unsigned long long)args.in[14]; tab[15] = (unsigned long long)args.in[15];
        tab[16] = (unsigned long long)args.in[16]; tab[17] = (unsigned long long)args.in[17]; tab[18] = (unsigned long long)args.out; tab[19] = (unsigned long long)args.ws;
    }
    if (tid == 0) { ((volatile LAS unsigned*)((LAS unsigned char*)lds + TAB_OFF + 224))[0] = 0u; ((volatile LAS unsigned*)((LAS unsigned char*)lds + TAB_OFF + 224))[1] = 0u; }
    __syncthreads();
    XcdBarrier bar = xcd_barrier_post((unsigned*)args.ws, (volatile LAS unsigned*)((LAS unsigned char*)lds + TAB_OFF + 224));
#define GSYNC() do { XcdBarrier b_; b_.bar = (unsigned*)rd_ptr(lds, 19); b_.x = xb_xcc_id(); b_.st = (volatile LAS unsigned*)((LAS unsigned char*)lds + TAB_OFF + 224); xcd_barrier(b_); } while (0)
#define INP(k) ((const float*)rd_ptr(lds, (k)))
#define WSP(off) ((unsigned char*)rd_ptr(lds, 19) + (off))
#define x_in INP(0)
#define c_in INP(1)
#define ctx_in INP(2)
#define cctx_in INP(3)
#define w_ada INP(4)
#define b_ada INP(5)
#define norm_mix INP(6)
#define norm_mlp INP(7)
#define w_in INP(8)
#define b_gates INP(9)
#define conv_qk INP(10)
#define q_norm INP(11)
#define k_norm INP(12)
#define mlstm_norm INP(13)
#define w_out INP(14)
#define w_mlp_in INP(15)
#define w_mlp_out INP(16)
#define norm_final INP(17)
#define MOD ((float*)WSP(WS_MOD))
#define WIN ((bf16*)WSP(WS_WIN))
#define WOUT ((bf16*)WSP(WS_WOUT))
#define W1 ((bf16*)WSP(WS_W1))
#define W2 ((bf16*)WSP(WS_W2))
#define X ((bf16*)WSP(WS_X))
#define XN ((bf16*)WSP(WS_XN))
#define HF ((bf16*)WSP(WS_XN))
#define HB ((bf16*)WSP(WS_HB))
#define AO ((bf16*)WSP(WS_AO))
#define PM ((bf16*)WSP(WS_PM))
#define KB ((bf16*)WSP(WS_K))
#define VB ((bf16*)WSP(WS_V))
#define GT ((float*)WSP(WS_G))
#define HH ((bf16*)WSP(WS_H))

        if (PHMASK & (1 << 0))
        for (int rep_ = 0; rep_ < REP_0; ++rep_)
    {
        float* sil = (float*)lds;
        float* red = (float*)(lds + 9 * 1024 * 4);
        for (int i = tid; i < 9 * 1024; i += 512) { const float v = (i < 8192) ? c_in[i] : cctx_in[i - 8192]; sil[i] = siluf_(v); }
        __syncthreads();
        for (int it = bx; it < DEPTH * 48; it += G) {
            const int l = it / 48, nb = it % 48; const int kq = tid >> 7, nn = tid & 127, n = nb * 128 + nn;
            const float* wp = w_ada + (size_t)l * 1024 * 6144 + (size_t)(kq * 256) * 6144 + n;
            float acc[9];
#pragma unroll
            for (int r = 0; r < 9; ++r) acc[r] = 0.f;
#pragma unroll 8
            for (int k = 0; k < 256; ++k) { const float wv = wp[(size_t)k * 6144];
#pragma unroll
                for (int r = 0; r < 9; ++r) acc[r] += sil[r * 1024 + kq * 256 + k] * wv; }
#pragma unroll
            for (int r = 0; r < 9; ++r) red[(kq * 9 + r) * 128 + nn] = acc[r];
            __syncthreads();
            for (int i = tid; i < 9 * 128; i += 512) { const int r = i >> 7, c = i & 127;
                const float s = red[(0 * 9 + r) * 128 + c] + red[(1 * 9 + r) * 128 + c] + red[(2 * 9 + r) * 128 + c] + red[(3 * 9 + r) * 128 + c];
                MOD[((size_t)l * 9 + r) * 6144 + nb * 128 + c] = s + b_ada[(size_t)l * 6144 + nb * 128 + c]; }
            __syncthreads();
        }
        {
            float* scr = (float*)(lds + wave * 8448);
            constexpr int I_IN = 16 * 96, I_OUT = 16 * 32, I_1 = 16 * 128, I_2 = 64 * 32;
            for (int it = gw; it < I_IN + I_OUT + I_1 + I_2; it += NGW) {
                int r = it;
                if (r < I_IN) { transpose_item(w_in, 1024, NIN, 96, WIN, scr, r, lane); continue; } r -= I_IN;
                if (r < I_OUT) { transpose_item(w_out, 1024, 1024, 32, WOUT, scr, r, lane); continue; } r -= I_OUT;
                if (r < I_1) { transpose_item(w_mlp_in, 1024, FF, 128, W1, scr, r, lane); continue; } r -= I_1;
                transpose_item(w_mlp_out, FF, 1024, 32, W2, scr, r, lane);
            }
        }
    }
    if (args.out == nullptr) grid.sync();
    GSYNC();

    for (int layer = 0; layer < DEPTH; ++layer) {
        const int tid = opaque_tid(), lane = tid & 63;
        const bool emit_ctx = layer < DEPTH - 1;
        const int Mout = emit_ctx ? MT : ML;
#define modl (MOD + (size_t)layer * 9 * 6144)
#define xlat (layer == 0 ? (const void*)x_in : (const void*)X)
#define xctx (layer == 0 ? (const void*)ctx_in : (const void*)(X + (size_t)ML * 1024))

        if (PHMASK & (1 << 1))
        for (int rep_ = 0; rep_ < REP_A; ++rep_)
        {
            float* scr = (float*)(lds + wave * 8448);
            constexpr int I_IN = 16 * 96, I_OUT = 16 * 32, I_1 = 16 * 128, I_2 = 64 * 32;
            if (layer > 0)
            for (int it = gw; it < I_IN + I_OUT + I_1 + I_2; it += NGW) {
                int r = it;
                if (r < I_IN) { transpose_item(w_in + (size_t)layer * 1024 * NIN, 1024, NIN, 96, WIN, scr, r, lane); continue; } r -= I_IN;
                if (r < I_OUT) { transpose_item(w_out + (size_t)layer * 1024 * 1024, 1024, 1024, 32, WOUT, scr, r, lane); continue; } r -= I_OUT;
                if (r < I_1) { transpose_item(w_mlp_in + (size_t)layer * 1024 * FF, 1024, FF, 128, W1, scr, r, lane); continue; } r -= I_1;
                transpose_item(w_mlp_out + (size_t)layer * FF * 1024, FF, 1024, 32, W2, scr, r, lane);
            }
            if (layer == 0) {
                for (int row = gw; row < ML; row += 8 * NGW)
                    modulate_rowsN<false, 8>(x_in, XN, row, NGW, modl, 0, 1024, norm_mix + layer * 1024, lane);
                for (int row = ML + gw; row < MT; row += NGW)
                    modulate_row<false>(ctx_in + (size_t)(row - ML) * 1024, XN + (size_t)row * 1024, norm_mix + layer * 1024, modl + 8 * 6144 + 0, modl + 8 * 6144 + 1024, lane);
            } else {
                for (int row = gw; row < ML; row += 8 * NGW)
                    modulate_rowsN<true, 8>(X, XN, row, NGW, modl, 0, 1024, norm_mix + layer * 1024, lane);
                if (rep_ + 1 >= REP_A)
                for (int row = ML + gw; row < MT; row += NGW)
                    modulate_row_part<true>(X + (size_t)row * 1024, X + (size_t)row * 1024, (const bf16*)rd_ptr(lds, 18) + (size_t)(row - ML) * 1024, MOD + ((size_t)(layer - 1) * 9 + 8) * 6144 + 5120,
                                            XN + (size_t)row * 1024, norm_mix + layer * 1024, modl + 8 * 6144 + 0, modl + 8 * 6144 + 1024, lane);
            }
        }
        GSYNC();

        if (PHMASK & (1 << 2))
        for (int rep_ = 0; rep_ < REP_B; ++rep_)
        {
            pg8::Gemm g{XN, WIN, MT, NINP, 1024, 0}; pg8::ThinLastOrder S; S.init(MT, G, bx);
            pg8::EpiIn E{AO, PM, (bf16*)rd_ptr(lds, 18), GT, b_gates + layer * 16};
            pg8::gemm_phase<pg8::EpiIn, pg8::ThinLastOrder, true, true, 11>((PG8_LAS unsigned char*)lds, g, S, E);
        }
        GSYNC();

        {
            const bf16* RAW = (const bf16*)rd_ptr(lds, 18);
            float cw[2][3][8];
#pragma unroll
            for (int p = 0; p < 2; ++p)
#pragma unroll
                for (int tap = 0; tap < 3; ++tap) { const float* cp = conv_qk + (size_t)layer * 3072 + tap * 1024 + 512 * p + 8 * lane;
                    const f32x4 c0 = *(const f32x4*)cp, c1 = *(const f32x4*)(cp + 4);
#pragma unroll
                    for (int e = 0; e < 4; ++e) { cw[p][tap][e] = c0[e]; cw[p][tap][4 + e] = c1[e]; } }
#define PC_CONV_ROWS(NR, ROWBASE, STRIDE) do { \
                v4u r0[NR][2], r1[NR][2], r2[NR][2]; \
                _Pragma("unroll") for (int q = 0; q < NR; ++q) { const int row = (ROWBASE) + q * (STRIDE); \
                    const bool islat = row < ML; const int t = islat ? row & 4095 : (row - ML) & 255; const int len = islat ? TL : TCX; \
                    const bool vm = t > 0, vp = t < len - 1; \
                    const bf16* rp = RAW + (size_t)row * 1024 + 8 * lane; \
                    const v4u z4 = (v4u){0u, 0u, 0u, 0u}; \
                    _Pragma("unroll") for (int p = 0; p < 2; ++p) { r1[q][p] = *(const v4u*)(rp + 512 * p); r0[q][p] = vm ? *(const v4u*)(rp + 512 * p - 1024) : z4; r2[q][p] = vp ? *(const v4u*)(rp + 512 * p + 1024) : z4; } } \
                _Pragma("unroll") for (int q = 0; q < NR; ++q) \
                    _Pragma("unroll") for (int p = 0; p < 2; ++p) { \
                        const float scl = p ? 0.08838834764831845f : 1.f; \
                        v4u o; \
                        _Pragma("unroll") for (int e = 0; e < 4; ++e) { \
                            const float x0 = cw[p][0][2 * e] * bflo(r0[q][p][e]) + cw[p][1][2 * e] * bflo(r1[q][p][e]) + cw[p][2][2 * e] * bflo(r2[q][p][e]); \
                            const float x1 = cw[p][0][2 * e + 1] * bfhi(r0[q][p][e]) + cw[p][1][2 * e + 1] * bfhi(r1[q][p][e]) + cw[p][2][2 * e + 1] * bfhi(r2[q][p][e]); \
                            const float y0 = x0 * __builtin_amdgcn_rcpf(1.f + __builtin_amdgcn_exp2f(-1.4426950408889634f * x0)) * scl; \
                            const float y1 = x1 * __builtin_amdgcn_rcpf(1.f + __builtin_amdgcn_exp2f(-1.4426950408889634f * x1)) * scl; \
                            o[e] = pk2(y0, y1); } \
                        *(v4u*)(PM + (size_t)((ROWBASE) + q * (STRIDE)) * 2048 + 512 * p + 8 * lane) = o; } } while (0)
            for (int row0 = gw; row0 < ML; row0 += 4 * NGW) PC_CONV_ROWS(4, row0, NGW);
            for (int row0 = ML + gw; row0 < MT; row0 += NGW) PC_CONV_ROWS(1, row0, 0);
#undef PC_CONV_ROWS
            float* GAp = (float*)WSP(WS_GA); float* BPp = (float*)WSP(WS_BP); float* CHp = (float*)WSP(WS_CH); const float* gates = GT;
            for (int it = gw; it < 64 * 34; it += NGW) {
                const int chain = it / 34, ci = it - chain * 34; const int b = chain >> 3, h = (chain >> 1) & 3, dir = chain & 1;
                const bool isctx = ci < 2; const int cc = isctx ? ci : ci - 2; const int len = isctx ? TCX : TL; const int rowbase = isctx ? ML + b * TCX : b * TL;
                const int gi = (dir ? 8 : 0) + h, gf = (dir ? 12 : 4) + h;
                const int i0 = 128 * cc + 2 * lane;
                const int tok0 = dir ? len - 1 - i0 : i0, tok1 = dir ? tok0 - 1 : tok0 + 1;
                const float* g0 = gates + (size_t)(rowbase + tok0) * 16; const float* g1 = gates + (size_t)(rowbase + tok1) * 16;
                const float ig0 = g0[gi], ig1 = g1[gi], lf0 = logsigmoidf_(g0[gf]), lf1 = logsigmoidf_(g1[gf]);
                float sc = lf0 + lf1;
#pragma unroll
                for (int o = 1; o < 64; o <<= 1) { const float tt = __shfl_up(sc, o); if (lane >= o) sc += tt; }
                const float b1 = sc, b0 = sc - lf1;
                const float a0 = ig0 - b0, a1 = ig1 - b1;
                float sm = fmaxf(a0, a1);
#pragma unroll
                for (int o = 1; o < 64; o <<= 1) { const float tt = __shfl_up(sm, o); if (lane >= o) sm = fmaxf(sm, tt); }
                float pme = __shfl_up(sm, 1); if (lane == 0) pme = -INFINITY;
                const float pm0 = fmaxf(pme, a0), pm1 = sm;
                const size_t base = (size_t)chain * KVLEN + 128 * ci + 2 * lane;
                *(float2*)(GAp + base) = make_float2(a0, a1);
                *(f32x4*)(BPp + 2 * base) = (f32x4){b0, pm0, b1, pm1};
                if (lane == 63) *(float2*)(CHp + 2 * (chain * 34 + ci)) = make_float2(b1, sm);
            }
        }
        {
            float2* rt = (float2*)lds;
            for (int i = tid; i < 1024; i += 512) { const int pp = i >> 4, fi = i & 15;
                const float invf = exp2f(-(float)(2 * fi) * (13.287712379549449f / 32.f)); float sv, cv; sincosf((float)pp * invf, &sv, &cv); rt[i] = make_float2(cv, sv); }
            __syncthreads();
            const int l8 = lane & 7, lk = lane & 15;
            float qg[8], kg[8];
#pragma unroll
            for (int e = 0; e < 8; ++e) { qg[e] = q_norm[layer * 64 + 8 * l8 + e] * attn_body::C2; kg[e] = k_norm[layer * 64 + 8 * l8 + e]; }
#define PC_QK_ROWS(NR, ROWBASE, STRIDE) do { \
                v4u rawq[NR], rawk[NR], rawv[NR]; \
                _Pragma("unroll") for (int q = 0; q < NR; ++q) { const bf16* ar = AO + (size_t)((ROWBASE) + q * (STRIDE)) * 1024; \
                    rawq[q] = *(const v4u*)(ar + 8 * lane); rawk[q] = *(const v4u*)(ar + 512 + 8 * lk); rawv[q] = *(const v4u*)(ar + 640 + 8 * lk); } \
                _Pragma("unroll") for (int q = 0; q < NR; ++q) { \
                    const int row = (ROWBASE) + q * (STRIDE); \
                    const bool islat = row < ML; const int b = islat ? row >> 12 : (row - ML) >> 8; const int t = islat ? row & 4095 : (row - ML) & 255; \
                    const int pos = islat ? TCX + t : t; \
                    bf16* ar = AO + (size_t)row * 1024; \
                    float cs[4], sn[4]; \
                    { const int pp = (l8 < 4) ? (t >> 6) : (t & 63); const f32x4* tp = (const f32x4*)(rt + pp * 16 + 4 * (l8 & 3)); \
                      const f32x4 t0 = tp[0], t1 = tp[1]; \
                      if (islat) { cs[0] = t0[0]; sn[0] = t0[1]; cs[1] = t0[2]; sn[1] = t0[3]; cs[2] = t1[0]; sn[2] = t1[1]; cs[3] = t1[2]; sn[3] = t1[3]; } \
                      else { cs[0] = cs[1] = cs[2] = cs[3] = 1.f; sn[0] = sn[1] = sn[2] = sn[3] = 0.f; } } \
                    { float v[8]; \
                        _Pragma("unroll") for (int e = 0; e < 4; ++e) { v[2 * e] = bflo(rawq[q][e]); v[2 * e + 1] = bfhi(rawq[q][e]); } \
                        float ss = 0.f; \
                        _Pragma("unroll") for (int e = 0; e < 8; ++e) ss += v[e] * v[e]; \
                        ss += __shfl_xor(ss, 1); ss += __shfl_xor(ss, 2); ss += __shfl_xor(ss, 4); \
                        const float r = rsqrtf(ss * (1.f / 64.f) + EPS); \
                        v4u o; \
                        _Pragma("unroll") for (int j = 0; j < 4; ++j) { const float x0 = v[2 * j] * r * qg[2 * j], x1 = v[2 * j + 1] * r * qg[2 * j + 1]; \
                            o[j] = pk2(x0 * cs[j] - x1 * sn[j], x0 * sn[j] + x1 * cs[j]); } \
                        *(v4u*)(ar + 8 * lane) = o; } \
                    { float v[8]; \
                        _Pragma("unroll") for (int e = 0; e < 4; ++e) { v[2 * e] = bflo(rawk[q][e]); v[2 * e + 1] = bfhi(rawk[q][e]); } \
                        float ss = 0.f; \
                        _Pragma("unroll") for (int e = 0; e < 8; ++e) ss += v[e] * v[e]; \
                        ss += __shfl_xor(ss, 1); ss += __shfl_xor(ss, 2); ss += __shfl_xor(ss, 4); \
                        const float r = rsqrtf(ss * (1.f / 64.f) + EPS); \
                        v4u o; \
                        _Pragma("unroll") for (int j = 0; j < 4; ++j) { const float x0 = v[2 * j] * r * kg[2 * j], x1 = v[2 * j + 1] * r * kg[2 * j + 1]; \
                            o[j] = pk2(x0 * cs[j] - x1 * sn[j], x0 * sn[j] + x1 * cs[j]); } \
                        const size_t kvrow = ((size_t)b * KVLEN + pos) * 128; \
                        if (lane < 16) *(v4u*)(KB + kvrow + 8 * lk) = o; \
                        else if (lane < 32) *(v4u*)(VB + kvrow + 8 * lk) = rawv[q]; } } } while (0)
            for (int row0 = gw; row0 < ML; row0 += 4 * NGW) PC_QK_ROWS(4, row0, NGW);
            for (int row0 = ML + gw; row0 < MT; row0 += NGW) PC_QK_ROWS(1, row0, 0);
#undef PC_QK_ROWS
        }
        GSYNC();

        {
            unsigned* ctr = (unsigned*)WSP(14336) + 64 * layer;
            unsigned* mdone = (unsigned*)WSP(15360) + 64 * layer;
            bool had_item = false;
            for (int item = (vcu & 1) ? 128 : (vcu >> 1); item < 128; item += (G >> 1)) {
                mlstm_item(item, PM, (const float*)WSP(WS_GA), (const float*)WSP(WS_BP), (const float*)WSP(WS_CH), HF, HB, (char*)lds); had_item = true; }
            if (had_item) {
                asm volatile("s_waitcnt vmcnt(0)" ::: "memory"); __syncthreads();
                if (tid == 0) { __builtin_amdgcn_fence(__ATOMIC_RELEASE, "agent"); asm volatile("s_waitcnt vmcnt(0)" ::: "memory");
                    int n_it = 0; for (int item = (vcu & 1) ? 128 : (vcu >> 1); item < 128; item += (G >> 1)) ++n_it;
                    __hip_atomic_fetch_add(mdone, (unsigned)n_it, __ATOMIC_RELAXED, __HIP_MEMORY_SCOPE_AGENT); }
            }
            __syncthreads();
            volatile LAS unsigned* uw = (volatile LAS unsigned*)((LAS unsigned char*)lds + TAB_OFF + 232);
            const int NPE = Mout / 128;
            const int total = 1024 + NPE + (emit_ctx ? 64 : 0);
            bool acquired = false;
            for (;;) {
                if (tid == 0) uw[0] = __hip_atomic_fetch_add(ctr, 1u, __ATOMIC_RELAXED, __HIP_MEMORY_SCOPE_AGENT);
                __syncthreads();
                const int u = __builtin_amdgcn_readfirstlane((int)uw[0]);
                if (u >= total) break;
                if (u < 1024) {
                    const int bkv = u >> 6, rem = u & 63, hq = rem >> 4, qb = rem & 15; const int b = bkv >> 1, kvh = bkv & 1, h = kvh * 4 + hq;
                    attn_body::attn_unit<8>((attn_body::bf16*)(AO + ((size_t)b * TL + qb * 256) * 1024 + h * 64), (attn_body::bf16*)(AO + ((size_t)b * TL + qb * 256) * 1024 + h * 64),
                                            (const attn_body::bf16*)(KB + (size_t)b * KVLEN * 128 + kvh * 64), (const attn_body::bf16*)(VB + (size_t)b * KVLEN * 128 + kvh * 64), KVLEN / 64, (char*)lds);
                } else if (u < 1024 + NPE) {
                    if (!acquired) {
                        if (tid == 0) { unsigned sp = 0; while (__hip_atomic_load(mdone, __ATOMIC_RELAXED, __HIP_MEMORY_SCOPE_AGENT) < 128u && ++sp < (1u << 22)) __builtin_amdgcn_s_sleep(8);
                            __builtin_amdgcn_fence(__ATOMIC_ACQUIRE, "agent"); asm volatile("s_waitcnt vmcnt(0)" ::: "memory"); }
                        __syncthreads(); acquired = true;
                    }
                    const int r0 = (u - 1024) * 128 + wave * 16;
                    float gnv[8];
#pragma unroll
                    for (int e = 0; e < 8; ++e) gnv[e] = mlstm_norm[layer * 512 + 8 * lane + e];
                    for (int rr = 0; rr < 16; rr += 8) {
                        const int row = r0 + rr;
                        v4u a[8], bq[8], og[8];
#pragma unroll
                        for (int q = 0; q < 8; ++q) { a[q] = *(const v4u*)(HF + (size_t)(row + q) * 512 + 8 * lane); bq[q] = *(const v4u*)(HB + (size_t)(row + q) * 512 + 8 * lane); og[q] = *(const v4u*)(PM + (size_t)(row + q) * 2048 + 1536 + 8 * lane); }
#pragma unroll
                        for (int q = 0; q < 8; ++q) {
                            float v[8]; float ss = 0.f;
#pragma unroll
                            for (int e = 0; e < 4; ++e) { v[2 * e] = bflo(a[q][e]) + bflo(bq[q][e]); v[2 * e + 1] = bfhi(a[q][e]) + bfhi(bq[q][e]); }
#pragma unroll
                            for (int e = 0; e < 8; ++e) ss += v[e] * v[e];
                            ss += __shfl_xor(ss, 1); ss += __shfl_xor(ss, 2); ss += __shfl_xor(ss, 4); ss += __shfl_xor(ss, 8);
                            const float r = rsqrtf(ss * (1.f / 128.f) + EPS);
                            v4u o;
#pragma unroll
                            for (int e = 0; e < 4; ++e) { const float s0 = __builtin_amdgcn_rcpf(1.f + __builtin_amdgcn_exp2f(-1.4426950408889634f * bflo(og[q][e]))), s1 = __builtin_amdgcn_rcpf(1.f + __builtin_amdgcn_exp2f(-1.4426950408889634f * bfhi(og[q][e])));
                                o[e] = pk2(s0 * v[2 * e] * r * gnv[2 * e], s1 * v[2 * e + 1] * r * gnv[2 * e + 1]); }
                            *(v4u*)(AO + (size_t)(row + q) * 1024 + 512 + 8 * lane) = o;
                        }
                    }
                    __syncthreads();
                } else {
                    const int c = u - 1024 - NPE, b = c >> 3, h = c & 7, kvh = h >> 2;
                    attn_body::attn_unit<8>((attn_body::bf16*)(AO + ((size_t)ML + b * TCX) * 1024 + h * 64), (attn_body::bf16*)(AO + ((size_t)ML + b * TCX) * 1024 + h * 64),
                                            (const attn_body::bf16*)(KB + (size_t)b * KVLEN * 128 + kvh * 64), (const attn_body::bf16*)(VB + (size_t)b * KVLEN * 128 + kvh * 64), TCX / 64, (char*)lds);
                }
            }
        }
        GSYNC();

        if (PHMASK & (1 << 6))
        for (int rep_ = 0; rep_ < REP_F; ++rep_)
        {
            pg8::Gemm g{AO, WOUT, Mout, 1024, 1024, 0}; pg8::SplitOrder S; S.init(G, bx, 1024, emit_ctx);
            pg8::EpiRes E{xlat, xctx, (rep_ + 1 < REP_F) ? XN : X, modl + 2048, (rep_ + 1 < REP_F) ? 32767u : 0xffffffffu, (bf16*)rd_ptr(lds, 18), layer > 0};
            pg8::gemm_phase<pg8::EpiRes, pg8::SplitOrder, true, true>((PG8_LAS unsigned char*)lds, g, S, E);
        }
        GSYNC();

        if (PHMASK & (1 << 7))
        for (int rep_ = 0; rep_ < REP_G; ++rep_)
        {
            for (int row = gw; row < ML; row += 8 * NGW)
                modulate_rowsN<true, 8>(X, XN, row, NGW, modl, 3072, 4096, norm_mlp + layer * 1024, lane);
            if (emit_ctx && rep_ + 1 >= REP_G)
                for (int row = ML + gw; row < MT; row += NGW) {
                    if (layer == 0) modulate_row_part<false>(ctx_in + (size_t)(row - ML) * 1024, X + (size_t)row * 1024, (const bf16*)rd_ptr(lds, 18) + (size_t)(row - ML) * 1024, modl + 8 * 6144 + 2048,
                                                             XN + (size_t)row * 1024, norm_mlp + layer * 1024, modl + 8 * 6144 + 3072, modl + 8 * 6144 + 4096, lane);
                    else modulate_row_part<true>(X + (size_t)row * 1024, X + (size_t)row * 1024, (const bf16*)rd_ptr(lds, 18) + (size_t)(row - ML) * 1024, modl + 8 * 6144 + 2048,
                                                 XN + (size_t)row * 1024, norm_mlp + layer * 1024, modl + 8 * 6144 + 3072, modl + 8 * 6144 + 4096, lane);
                }
        }
        GSYNC();

        if (PHMASK & (1 << 8))
        for (int rep_ = 0; rep_ < REP_H; ++rep_)
        {
            pg8::Gemm g{XN, W1, Mout, FF, 1024, 0}; pg8::StaticOrder S; S.init(Mout, FF, G, bx); S.ntf = 16;
            pg8::EpiUp E{HH};
            pg8::gemm_phase<pg8::EpiUp, pg8::StaticOrder, true, true>((PG8_LAS unsigned char*)lds, g, S, E);
        }
        GSYNC();

        if (PHMASK & (1 << 9))
        for (int rep_ = 0; rep_ < REP_I; ++rep_)
        {
            pg8::Gemm g{HH, W2, Mout, 1024, FF, 1}; pg8::SplitOrder S; S.init(G, bx, FF, emit_ctx);
            pg8::EpiRes E{X, X + (size_t)ML * 1024, (rep_ + 1 < REP_I) ? XN : X, modl + 5120, (rep_ + 1 < REP_I) ? 32767u : 0xffffffffu, (bf16*)rd_ptr(lds, 18), 1};
            pg8::gemm_phase<pg8::EpiRes, pg8::SplitOrder, true, true>((PG8_LAS unsigned char*)lds, g, S, E);
        }
        GSYNC();
    }

        if (PHMASK & (1 << 10))
        for (int rep_ = 0; rep_ < REP_Z; ++rep_)
    for (int row = gw; row < ML; row += 4 * NGW) {
        f32x4 v[4][4]; float ss[4];
#pragma unroll
        for (int q = 0; q < 4; ++q)
#pragma unroll
            for (int j = 0; j < 4; ++j) v[q][j] = ldx4<true>(X + (size_t)(row + q * NGW) * 1024, lane + 64 * j);
#pragma unroll
        for (int q = 0; q < 4; ++q) { float a = 0.f;
#pragma unroll
            for (int j = 0; j < 4; ++j) a += (v[q][j].x * v[q][j].x + v[q][j].y * v[q][j].y) + (v[q][j].z * v[q][j].z + v[q][j].w * v[q][j].w);
            ss[q] = a; }
#pragma unroll
        for (int o = 1; o < 64; o <<= 1) {
#pragma unroll
            for (int q = 0; q < 4; ++q) ss[q] += __shfl_xor(ss[q], o); }
#pragma unroll
        for (int q = 0; q < 4; ++q) { const float r = rsqrtf(ss[q] * (1.f / DM) + EPS);
            f32x4* o = (f32x4*)((float*)rd_ptr(lds, 18) + (size_t)(row + q * NGW) * 1024) + lane;
#pragma unroll
            for (int j = 0; j < 4; ++j) o[64 * j] = v[q][j] * r * *(const f32x4*)(norm_final + 4 * lane + 256 * j); }
    }
}

extern "C" void kernel_launch(void* const* d_in, const int* in_sizes, int n_in, void* d_out, int out_size, void* d_ws, size_t ws_size, hipStream_t stream) {
    static int grid = 0;
    if (grid == 0) {
        if (n_in != 18 || in_sizes[0] != ML * DM || out_size != ML * DM || ws_size < WS_END) {
            fprintf(stderr, "kernel_launch: unexpected shapes: n_in %d in0 %d out %d ws %zu (need %zu)\n", n_in, n_in > 0 ? in_sizes[0] : -1, out_size, ws_size, (size_t)WS_END); grid = -1; return; }
        int dev = 0, cus = 0, per_cu = 0;
        (void)hipGetDevice(&dev); (void)hipDeviceGetAttribute(&cus, hipDeviceAttributeMultiprocessorCount, dev);
        if (hipFuncSetAttribute((const void*)hybrid_fwd, hipFuncAttributeMaxDynamicSharedMemorySize, LDS_BYTES) != hipSuccess) { fprintf(stderr, "kernel_launch: hipFuncSetAttribute failed\n"); grid = -1; return; }
        if (hipOccupancyMaxActiveBlocksPerMultiprocessor(&per_cu, (const void*)hybrid_fwd, 512, LDS_BYTES) != hipSuccess || per_cu < 1) { fprintf(stderr, "kernel_launch: occupancy query says %d\n", per_cu); per_cu = 1; }
        (void)hipGetLastError();
        if (cus != 256) { fprintf(stderr, "kernel_launch: built for 256 CUs (MI355X), found %d; nothing launched\n", cus); grid = -1; return; }
        grid = cus * 1;
    }
    if (grid < 0) return;
    if (hipMemsetAsync(d_ws, 0, 16384, stream) != hipSuccess) { fprintf(stderr, "kernel_launch: memset failed\n"); return; }
    Args a{};
    for (int i = 0; i < 18; ++i) a.in[i] = (const float*)d_in[i];
    a.out = (float*)d_out; a.ws = (unsigned char*)d_ws;
    void* kargs[] = {&a};
    hipError_t e = hipLaunchCooperativeKernel((const void*)hybrid_fwd, dim3(grid), dim3(512), kargs, LDS_BYTES, stream);
    if (e != hipSuccess) fprintf(stderr, "kernel_launch: cooperative launch failed: %s (grid %d)\n", hipGetErrorString(e), grid);
}
```

```cpp
#include <hip/hip_runtime.h>
#include <hip/hip_cooperative_groups.h>
#include <cstdio>
#include <cstdint>
namespace cg = cooperative_groups;
#ifndef REP_A
#define REP_A 1
#endif
#ifndef REP_B
#define REP_B 1
#endif
#ifndef REP_E
#define REP_E 1
#endif
#ifndef REP_G
#define REP_G 1
#endif
#ifndef REP_H
#define REP_H 1
#endif
#ifndef ATT_REPS
#define ATT_REPS 1
#endif
#ifndef REP_F
#define REP_F 1
#endif
#ifndef REP_I
#define REP_I 1
#endif
#ifndef REP_0
#define REP_0 1
#endif
#ifndef REP_C
#define REP_C 1
#endif
#ifndef REP_Z
#define REP_Z 1
#endif
#ifndef MLSTM_REPS
#define MLSTM_REPS 1
#endif
#ifndef PHMASK
#define PHMASK 0x7ff
#endif
__device__ __forceinline__ int opaque_tid() { int t = threadIdx.x; asm volatile("" : "+v"(t)); return t; }
namespace pg8 {
#define PG8_LAS __attribute__((address_space(3)))
typedef unsigned short bf16_t;
typedef short bf16x8 __attribute__((ext_vector_type(8)));
typedef float f32x4 __attribute__((ext_vector_type(4)));
typedef unsigned u32x4 __attribute__((ext_vector_type(4)));
constexpr int BM = 256, BK = 64, HALF = 128, HTB = HALF * BK * 2  , STAGE_BYTES = 8 * HTB, NXCD = 8, WGM = 8;

__host__ __device__ __forceinline__ int lds_byte(int r, int c) { const int st = (r >> 4) * 2 + (c >> 5), rr = r & 15, cc = c & 31, ob = rr * 64 + cc * 2; return st * 1024 + (ob ^ (((ob >> 9) & 1) << 5)); }
__host__ __device__ __forceinline__ void stage_rc(int b, int& R, int& C) { const int st = b / 1024, sb = b % 1024, swz = sb ^ (((sb >> 9) & 1) << 5); R = (st >> 1) * 16 + swz / 64; C = (st & 1) * 32 + (swz % 64) / 2; }
__host__ __device__ __forceinline__ int perm32(int rho) { const int n = rho >> 4, i = rho & 15; return 8 * (i >> 2) + 4 * n + (i & 3); }

struct Unit { int pm, pn, k0, nt, sl; };
struct Gemm { const bf16_t* A; const bf16_t* Bt; int M, N, K, ablk; };

struct StaticOrder {
    int nM, nN, nwg, G, c, ntf;
    __host__ __device__ void init(int M, int N, int G_, int c_) { nM = M / BM; nN = N / BM; nwg = nM * nN; G = G_; c = c_; }
    __host__ __device__ bool next(int i, Unit& u) const {
        const long L = (long)i * G + c; if (L >= nwg) return false;
        int wgid = (int)L; { const int q = nwg / NXCD, r = nwg % NXCD, xcd = wgid % NXCD, off = wgid / NXCD; wgid = (xcd < r ? xcd * (q + 1) : r * (q + 1) + (xcd - r) * q) + off; }
        const int nig = WGM * nN, gid = wgid / nig, fm = gid * WGM, gsz = (nM - fm) < WGM ? (nM - fm) : WGM;
        u = Unit{fm + ((wgid % nig) % gsz), (wgid % nig) / gsz, 0, ntf, -1}; return true;
    }
    __device__ __forceinline__ void a_ready(const Unit&) const {}
    __device__ __forceinline__ void done(const Unit&) const {}
};
struct ThinLastOrder {
    StaticOrder L; int nthin;
    __host__ __device__ void init(int M, int G_, int c_) { L.init(M, 11 * 256, G_, c_); L.ntf = 16; nthin = M / BM; }
    __host__ __device__ bool next(int i, Unit& u) const {
        const long idx = (long)i * L.G + L.c;
        if (idx < L.nwg) return L.next(i, u);
        const long t = idx - L.nwg; if (t >= nthin) return false;
        u = Unit{(int)t, 11, 0, L.ntf, -1}; return true;
    }
    __device__ __forceinline__ void a_ready(const Unit&) const {}
    __device__ __forceinline__ void done(const Unit&) const {}
};
struct SplitOrder {
    StaticOrder L; int rl, nsplit;
    __host__ __device__ void init(int G_, int c_, int K, bool with_ctx) { L.init(32768, 1024, G_, c_); L.ntf = K / 64; rl = (c_ < L.nwg) ? (L.nwg - c_ + G_ - 1) / G_ : 0; nsplit = with_ctx ? 256 : 0; }
    __host__ __device__ bool next(int i, Unit& u) const {
        if (i < rl) return L.next(i, u);
        const int j = i - rl; const long sidx = (long)j * L.G + L.c; if (sidx >= nsplit) return false;
        const int tile = (int)sidx >> 3, slice = (int)sidx & 7, nts = L.ntf / 8; u = Unit{128 + (tile >> 2), tile & 3, slice * nts * 64, nts, slice}; return true;
    }
    __device__ __forceinline__ void a_ready(const Unit&) const {}
    __device__ __forceinline__ void done(const Unit&) const {}
};

__device__ __forceinline__ unsigned cvt_pk_bf16(float lo, float hi) { unsigned r; asm volatile("v_cvt_pk_bf16_f32 %0, %1, %2" : "=v"(r) : "v"(lo), "v"(hi)); return r; }
typedef float f32x2 __attribute__((ext_vector_type(2)));
__device__ __forceinline__ f32x2 gelu_pk(f32x2 v) {
    const f32x2 av = __builtin_elementwise_abs(v), d = av * 0.2316418882f + 1.0f;
    f32x2 t; t.x = __builtin_amdgcn_rcpf(d.x); t.y = __builtin_amdgcn_rcpf(d.y);
    f32x2 q = t * 0.5307027145f + (-0.7265760135f); q = q * t + 0.7107068705f; q = q * t + (-0.142248368f); q = q * t + 0.127414796f; q = q * t;
    const f32x2 s = (v * v) * (-0.72134752044f);
    f32x2 e; e.x = __builtin_amdgcn_exp2f(s.x); e.y = __builtin_amdgcn_exp2f(s.y);
    const f32x2 m = v * (q * e), r = v - m;
    f32x2 o; o.x = v.x < 0.f ? m.x : r.x; o.y = v.y < 0.f ? m.y : r.y; return o;
}

constexpr int ML_ROWS = 32768;
struct EpiIn {
    static constexpr bool PERM = true, AFTER_DRAIN = false;
    bf16_t* AO; bf16_t* PM; bf16_t* RAW; float* gates; const float* bg;
    __device__ __forceinline__ void operator()(const f32x4 (&acc)[2][2][4][2], const Unit& u, int wr, int wc, int fr, int fq) const {
        const int row0 = u.pm * BM + wr * 64 + fr;
        if (u.pn < 11) {
            bf16_t* base; int ldc, colt;
            if (u.pn < 3) { base = AO; ldc = 1024; colt = u.pn * 256; } else if (u.pn < 7) { base = RAW; ldc = 1024; colt = (u.pn - 3) * 256; } else { base = PM; ldc = 2048; colt = (u.pn - 3) * 256; }
            const int col0 = colt + wc * 32 + 8 * fq;
#pragma unroll
            for (int ai = 0; ai < 2; ++ai)
#pragma unroll
                for (int m = 0; m < 4; ++m) { bf16_t* rowp = base + (size_t)(row0 + ai * HALF + m * 16) * ldc + col0;
#pragma unroll
                    for (int bj = 0; bj < 2; ++bj) { const f32x4 v0 = acc[ai][bj][m][0], v1 = acc[ai][bj][m][1];
                        u32x4 w; w.x = cvt_pk_bf16(v0[0], v0[1]); w.y = cvt_pk_bf16(v0[2], v0[3]); w.z = cvt_pk_bf16(v1[0], v1[1]); w.w = cvt_pk_bf16(v1[2], v1[3]);
                        *(u32x4*)(rowp + bj * HALF) = w; } }
        } else {
            if (wc == 0 && fq < 2) {
                const f32x4 b0 = *(const f32x4*)(bg + 8 * fq), b1 = *(const f32x4*)(bg + 8 * fq + 4);
#pragma unroll
                for (int ai = 0; ai < 2; ++ai)
#pragma unroll
                    for (int m = 0; m < 4; ++m) { float* rowp = gates + (size_t)(row0 + ai * HALF + m * 16) * 16 + 8 * fq;
                        *(f32x4*)(rowp) = acc[ai][0][m][0] + b0; *(f32x4*)(rowp + 4) = acc[ai][0][m][1] + b1; }
            }
        }
    }
};
struct EpiRes {
    static constexpr bool PERM = true, AFTER_DRAIN = false;
    const void* xlat; const void* xctx; bf16_t* X; const float* gmod; unsigned rowmask; bf16_t* PART; int xbf;
    __device__ __forceinline__ void operator()(const f32x4 (&acc)[2][2][4][2], const Unit& u, int wr, int wc, int fr, int fq) const {
        const int row0 = u.pm * BM + wr * 64 + fr;
        const int mr = (u.pm < 128) ? (u.pm >> 4) : 8;
        const int col0 = u.pn * BM + wc * 32 + 8 * fq;
        const float* gp = gmod + (size_t)mr * 6144 + col0;
        if (u.sl >= 0) {
            bf16_t* pp = PART + ((size_t)u.sl * 2048 + (row0 - ML_ROWS)) * 1024 + col0;
#pragma unroll
            for (int ai = 0; ai < 2; ++ai)
#pragma unroll
                for (int m = 0; m < 4; ++m)
#pragma unroll
                    for (int bj = 0; bj < 2; ++bj) { bf16_t* q = pp + (size_t)(ai * HALF + m * 16) * 1024 + bj * HALF; const f32x4 v0 = acc[ai][bj][m][0], v1 = acc[ai][bj][m][1];
                        u32x4 w; w.x = cvt_pk_bf16(v0[0], v0[1]); w.y = cvt_pk_bf16(v0[2], v0[3]); w.z = cvt_pk_bf16(v1[0], v1[1]); w.w = cvt_pk_bf16(v1[2], v1[3]); *(u32x4*)q = w; }
            return;
        }
        f32x4 gv[2][2];
#pragma unroll
        for (int bj = 0; bj < 2; ++bj) { gv[bj][0] = *(const f32x4*)(gp + bj * HALF); gv[bj][1] = *(const f32x4*)(gp + bj * HALF + 4); }
        if (xbf) {
#pragma unroll
            for (int ai = 0; ai < 2; ++ai)
#pragma unroll
                for (int mp = 0; mp < 2; ++mp) {
                    u32x4 xr[2][2];
#pragma unroll
                    for (int mm = 0; mm < 2; ++mm) { const int row = row0 + ai * HALF + (2 * mp + mm) * 16;
                        const size_t rin = (row < ML_ROWS) ? (size_t)row : (size_t)(row - ML_ROWS);
                        const char* xin = (const char*)((row < ML_ROWS) ? xlat : xctx);
#pragma unroll
                        for (int bj = 0; bj < 2; ++bj) xr[mm][bj] = *(const u32x4*)(xin + (rin * 1024 + col0 + bj * HALF) * 2); }
#pragma unroll
                    for (int mm = 0; mm < 2; ++mm) { const int m = 2 * mp + mm; const int row = row0 + ai * HALF + m * 16;
                        bf16_t* xo = X + (size_t)((unsigned)row & rowmask) * 1024;
#pragma unroll
                        for (int bj = 0; bj < 2; ++bj) { const int c = col0 + bj * HALF; const u32x4 w = xr[mm][bj];
                            const f32x4 a0 = (f32x4){__builtin_bit_cast(float, w.x << 16), __builtin_bit_cast(float, w.x & 0xffff0000u), __builtin_bit_cast(float, w.y << 16), __builtin_bit_cast(float, w.y & 0xffff0000u)};
                            const f32x4 a1 = (f32x4){__builtin_bit_cast(float, w.z << 16), __builtin_bit_cast(float, w.z & 0xffff0000u), __builtin_bit_cast(float, w.w << 16), __builtin_bit_cast(float, w.w & 0xffff0000u)};
                            const f32x4 x0 = a0 + gv[bj][0] * acc[ai][bj][m][0], x1 = a1 + gv[bj][1] * acc[ai][bj][m][1];
                            u32x4 o; o.x = cvt_pk_bf16(x0[0], x0[1]); o.y = cvt_pk_bf16(x0[2], x0[3]); o.z = cvt_pk_bf16(x1[0], x1[1]); o.w = cvt_pk_bf16(x1[2], x1[3]);
                            *(u32x4*)(xo + c) = o; } }
                    asm volatile("" ::: "memory");
                }
        } else {
#pragma unroll
            for (int ai = 0; ai < 2; ++ai)
#pragma unroll
                for (int m = 0; m < 4; ++m) { const int row = row0 + ai * HALF + m * 16;
                    const size_t rin = (row < ML_ROWS) ? (size_t)row : (size_t)(row - ML_ROWS);
                    const char* xin = (const char*)((row < ML_ROWS) ? xlat : xctx);
                    bf16_t* xo = X + (size_t)((unsigned)row & rowmask) * 1024;
#pragma unroll
                    for (int bj = 0; bj < 2; ++bj) { const int c = col0 + bj * HALF;
                        const f32x4 a0 = *(const f32x4*)(xin + (rin * 1024 + c) * 4), a1 = *(const f32x4*)(xin + (rin * 1024 + c) * 4 + 16);
                        const f32x4 x0 = a0 + gv[bj][0] * acc[ai][bj][m][0], x1 = a1 + gv[bj][1] * acc[ai][bj][m][1];
                        u32x4 o; o.x = cvt_pk_bf16(x0[0], x0[1]); o.y = cvt_pk_bf16(x0[2], x0[3]); o.z = cvt_pk_bf16(x1[0], x1[1]); o.w = cvt_pk_bf16(x1[2], x1[3]);
                        *(u32x4*)(xo + c) = o; } }
        }
    }
};
struct EpiUp {
    static constexpr bool PERM = true, AFTER_DRAIN = false;
    bf16_t* H;
    __device__ __forceinline__ void operator()(const f32x4 (&acc)[2][2][4][2], const Unit& u, int wr, int wc, int fr, int fq) const {
        const int row0 = u.pm * BM + wr * 64 + fr; const int col0 = u.pn * BM + wc * 32 + 8 * fq;
#pragma unroll
        for (int ai = 0; ai < 2; ++ai)
#pragma unroll
            for (int m = 0; m < 4; ++m) { const int row = row0 + ai * HALF + m * 16;
                bf16_t* rowp = H + ((size_t)((row >> 8) * 64 + (col0 >> 6)) * 256 + (row & 255)) * 64 + (col0 & 63);
#pragma unroll
                for (int bj = 0; bj < 2; ++bj) { f32x4 v0 = acc[ai][bj][m][0], v1 = acc[ai][bj][m][1];
#pragma unroll
                    for (int e = 0; e < 4; ++e) { const float a = fmaxf(v0[e], 0.f), b = fmaxf(v1[e], 0.f); v0[e] = a * a; v1[e] = b * b; }
                    u32x4 w; w.x = cvt_pk_bf16(v0[0], v0[1]); w.y = cvt_pk_bf16(v0[2], v0[3]); w.z = cvt_pk_bf16(v1[0], v1[1]); w.w = cvt_pk_bf16(v1[2], v1[3]);
                    *(u32x4*)(rowp + (size_t)bj * 2 * 256 * 64) = w; } }
    }
};
template <class Epi, class Sched, bool ALIGN_EPI = false, bool SP2 = false, int THIN_PN = -1>
__device__ __forceinline__ void gemm_phase(PG8_LAS unsigned char* lds, const Gemm g, const Sched& S, const Epi& E) {
    const int tid = opaque_tid(), wid = __builtin_amdgcn_readfirstlane(tid >> 6), lane = tid & 63, wr = wid >> 2, wc = wid & 3, fr = lane & 15, fq = lane >> 4;
    const int K = g.K;
    unsigned voffA[2], voffB[2];
#pragma unroll
    for (int i = 0; i < 2; ++i) { int R, C; stage_rc(tid * 16 + i * 8192, R, C); const int Rb = Epi::PERM ? ((R & ~31) + perm32(R & 31)) : R;
        voffA[i] = (unsigned)(R * (g.ablk ? BK : K) + C) * 2u; voffB[i] = (unsigned)(Rb * K + C) * 2u; }
    const size_t kstep = (size_t)(BK * 2);
    const size_t hstep = (size_t)HALF * K * 2;
    const size_t tstep = 2 * hstep;
    const size_t kstepA = g.ablk ? (size_t)BM * BK * 2 : kstep, hstepA = g.ablk ? (size_t)HALF * BK * 2 : hstep;
    const unsigned ldsw = (unsigned)wid * 1024u;
    const int aoff = lds_byte(wr * 64 + fr, fq * 8), boff = lds_byte(wc * 32 + fr, fq * 8);
#define PG8_SA(b, h) (((b) * 2 + (h)) * HTB)
#define PG8_SB(b, h) ((4 + (b) * 2 + (h)) * HTB)
#define PG8_STAGE(bufoff, gbase, voff) do { _Pragma("unroll") for (int _i = 0; _i < 2; ++_i) \
        __builtin_amdgcn_global_load_lds((const unsigned*)((const char*)(gbase) + (voff)[_i]), (PG8_LAS unsigned*)(lds + (bufoff) + ldsw + _i * 8192), 16, 0, 0); } while (0)
#define PG8_LDA(dst, b, h) do { _Pragma("unroll") for (int m = 0; m < 4; ++m) _Pragma("unroll") for (int k = 0; k < 2; ++k) dst[m][k] = *(const PG8_LAS bf16x8*)(lds + PG8_SA(b, h) + aoff + m * 2048 + k * 1024); } while (0)
#define PG8_LDB(dst, b, h) do { _Pragma("unroll") for (int n = 0; n < 2; ++n) _Pragma("unroll") for (int k = 0; k < 2; ++k) dst[n][k] = *(const PG8_LAS bf16x8*)(lds + PG8_SB(b, h) + boff + n * 2048 + k * 1024); } while (0)
#define PG8_MMA(ai, bj, At, Bt) do { __builtin_amdgcn_s_setprio(1); _Pragma("unroll") for (int m = 0; m < 4; ++m) _Pragma("unroll") for (int n = 0; n < 2; ++n) _Pragma("unroll") for (int k = 0; k < 2; ++k) \
        acc[ai][bj][m][n] = __builtin_amdgcn_mfma_f32_16x16x32_bf16(Bt[n][k], At[m][k], acc[ai][bj][m][n], 0, 0, 0); __builtin_amdgcn_s_setprio(0); } while (0)
#define PG8_MMAT(ai, bj, At, Bt) do { if (THIN_PN < 0 || !(thin && ((bj) != 0 || wc != 0))) PG8_MMA(ai, bj, At, Bt); } while (0)
#define PG8_WAIT_V(n) asm volatile("s_waitcnt vmcnt(" #n ")" ::: "memory")
#define PG8_WAIT_L(n) asm volatile("s_waitcnt lgkmcnt(" #n ")" ::: "memory")
#define PG8_BAR __builtin_amdgcn_s_barrier()
#define PG8_SCHED __builtin_amdgcn_sched_barrier(0)
    Unit cur, nxt; int ui = 0;
    if (!S.next(0, cur)) return;
    f32x4 acc[2][2][4][2];
#pragma unroll
    for (int a = 0; a < 2; ++a)
#pragma unroll
        for (int b = 0; b < 2; ++b)
#pragma unroll
            for (int m = 0; m < 4; ++m)
#pragma unroll
                for (int n = 0; n < 2; ++n) acc[a][b][m][n] = (f32x4){0.f, 0.f, 0.f, 0.f};
    bf16x8 At[4][2], B0[2][2], B1[2][2];
    const char* cA = (const char*)g.A + (size_t)cur.pm * tstep + (size_t)(cur.k0 / BK) * kstepA; const char* cB = (const char*)g.Bt + (size_t)cur.pn * tstep + (size_t)cur.k0 * 2;
    S.a_ready(cur);
    if constexpr (SP2) {
        PG8_STAGE(PG8_SB(0, 0), cB, voffB); PG8_STAGE(PG8_SB(0, 1), cB + hstep, voffB); PG8_STAGE(PG8_SA(0, 0), cA, voffA); PG8_STAGE(PG8_SA(0, 1), cA + hstepA, voffA);
        if (wr == 1) PG8_BAR;
        PG8_WAIT_V(2); PG8_BAR;
        PG8_STAGE(PG8_SB(1, 0), cB + kstep, voffB); PG8_STAGE(PG8_SA(1, 0), cA + kstepA, voffA); PG8_STAGE(PG8_SB(1, 1), cB + hstep + kstep, voffB);
        PG8_WAIT_V(6); PG8_BAR;
    } else {
        PG8_STAGE(PG8_SB(0, 0), cB, voffB); PG8_STAGE(PG8_SA(0, 0), cA, voffA); PG8_STAGE(PG8_SB(0, 1), cB + hstep, voffB); PG8_STAGE(PG8_SA(0, 1), cA + hstepA, voffA);
        if (wr == 1) PG8_BAR;
        PG8_WAIT_V(4); PG8_BAR;
        PG8_STAGE(PG8_SB(1, 0), cB + kstep, voffB); PG8_STAGE(PG8_SA(1, 0), cA + kstepA, voffA); PG8_STAGE(PG8_SB(1, 1), cB + hstep + kstep, voffB);
        PG8_WAIT_V(6); PG8_BAR;
    }
    for (;;) {
        const bool has_next = S.next(ui + 1, nxt);
        const char* nA = has_next ? (const char*)g.A + (size_t)nxt.pm * tstep + (size_t)(nxt.k0 / BK) * kstepA : cA; const char* nB = has_next ? (const char*)g.Bt + (size_t)nxt.pn * tstep + (size_t)nxt.k0 * 2 : cB;
        const int nt = cur.nt;
        const bool thin = (THIN_PN >= 0) && (cur.pn == THIN_PN);
        for (int t = 0; t < nt; t += 2) {
            const bool last = (t == nt - 2);
            const char* a1 = cA + (size_t)(t + 1) * kstepA;
            const char* a2 = last ? nA : cA + (size_t)(t + 2) * kstepA; const char* b2 = last ? nB : cB + (size_t)(t + 2) * kstep;
            const char* a3 = a2 + kstepA; const char* b3 = b2 + kstep;
            if (last && has_next) S.a_ready(nxt);
            if constexpr (SP2) {
            PG8_LDB(B0, 0, 0); PG8_LDB(B1, 0, 1); PG8_SCHED; PG8_LDA(At, 0, 0); PG8_STAGE(PG8_SA(1, 1), a1 + hstepA, voffA);
            PG8_WAIT_V(8); PG8_WAIT_L(0); PG8_BAR; PG8_MMAT(0, 0, At, B0); PG8_MMAT(0, 1, At, B1); PG8_BAR; PG8_SCHED;
            PG8_LDA(At, 0, 1); PG8_STAGE(PG8_SB(0, 0), b2, voffB); PG8_STAGE(PG8_SB(0, 1), b2 + hstep, voffB); PG8_STAGE(PG8_SA(0, 0), a2, voffA);
            PG8_WAIT_V(8); PG8_WAIT_L(0); PG8_BAR; PG8_MMAT(1, 0, At, B0); PG8_MMAT(1, 1, At, B1); PG8_BAR; PG8_SCHED;
            PG8_LDB(B0, 1, 0); PG8_LDB(B1, 1, 1); PG8_SCHED; PG8_LDA(At, 1, 0); PG8_STAGE(PG8_SA(0, 1), a2 + hstepA, voffA);
            PG8_WAIT_V(8); PG8_WAIT_L(0); PG8_BAR; PG8_MMAT(0, 0, At, B0); PG8_MMAT(0, 1, At, B1); PG8_BAR; PG8_SCHED;
            PG8_LDA(At, 1, 1); PG8_STAGE(PG8_SB(1, 0), b3, voffB); PG8_STAGE(PG8_SB(1, 1), b3 + hstep, voffB); PG8_STAGE(PG8_SA(1, 0), a3, voffA);
            PG8_WAIT_V(8); PG8_WAIT_L(0); PG8_BAR; PG8_MMAT(1, 0, At, B0); PG8_MMAT(1, 1, At, B1); PG8_BAR; PG8_SCHED;
            } else {
            PG8_LDB(B0, 0, 0); PG8_SCHED; PG8_LDA(At, 0, 0); PG8_STAGE(PG8_SA(1, 1), a1 + hstepA, voffA);
            PG8_WAIT_L(8); PG8_BAR; PG8_WAIT_L(0); PG8_MMAT(0, 0, At, B0); PG8_BAR; PG8_SCHED;
            PG8_LDB(B1, 0, 1); PG8_STAGE(PG8_SB(0, 0), b2, voffB);
            PG8_BAR; PG8_WAIT_L(0); PG8_MMAT(0, 1, At, B1); PG8_BAR;
            PG8_LDA(At, 0, 1); PG8_STAGE(PG8_SA(0, 0), a2, voffA);
            PG8_BAR; PG8_WAIT_L(0); PG8_MMAT(1, 0, At, B0); PG8_BAR; PG8_SCHED;
            PG8_STAGE(PG8_SB(0, 1), b2 + hstep, voffB);
            PG8_WAIT_V(6); PG8_BAR; PG8_MMAT(1, 1, At, B1); PG8_BAR;
            PG8_LDB(B0, 1, 0); PG8_SCHED; PG8_LDA(At, 1, 0); PG8_STAGE(PG8_SA(0, 1), a2 + hstepA, voffA);
            PG8_WAIT_L(8); PG8_BAR; PG8_WAIT_L(0); PG8_MMAT(0, 0, At, B0); PG8_BAR; PG8_SCHED;
            PG8_LDB(B1, 1, 1); PG8_STAGE(PG8_SB(1, 0), b3, voffB);
            PG8_BAR; PG8_WAIT_L(0); PG8_MMAT(0, 1, At, B1); PG8_BAR;
            PG8_LDA(At, 1, 1); PG8_STAGE(PG8_SA(1, 0), a3, voffA);
            PG8_BAR; PG8_WAIT_L(0); PG8_MMAT(1, 0, At, B0); PG8_BAR; PG8_SCHED;
            PG8_STAGE(PG8_SB(1, 1), b3 + hstep, voffB);
            PG8_WAIT_V(6); PG8_BAR; PG8_MMAT(1, 1, At, B1); PG8_BAR;
            }
        }
        if constexpr (ALIGN_EPI) { if (wr == 0) PG8_BAR; }
        if constexpr (!Epi::AFTER_DRAIN) { E(acc, cur, wr, wc, fr, fq); S.done(cur); }
        if (!has_next) break;
#pragma unroll
        for (int a = 0; a < 2; ++a)
#pragma unroll
            for (int b = 0; b < 2; ++b)
#pragma unroll
                for (int m = 0; m < 4; ++m)
#pragma unroll
                    for (int n = 0; n < 2; ++n) acc[a][b][m][n] = (f32x4){0.f, 0.f, 0.f, 0.f};
        cur = nxt; cA = nA; cB = nB; ++ui;
        if constexpr (ALIGN_EPI) { if (wr == 1) PG8_BAR; }
    }
    PG8_WAIT_V(0);
    if constexpr (!ALIGN_EPI) { if (wr == 0) PG8_BAR; }
    PG8_BAR;
    if constexpr (Epi::AFTER_DRAIN) { E.fused(acc, cur, wr, wc, fr, fq, lds, wid, lane); S.done(cur); }
#undef PG8_SA
#undef PG8_SB
#undef PG8_STAGE
#undef PG8_LDA
#undef PG8_LDB
#undef PG8_MMA
#undef PG8_MMAT
#undef PG8_WAIT_V
#undef PG8_WAIT_L
#undef PG8_BAR
#undef PG8_SCHED
}
}
#include <hip/hip_bf16.h>
#include <cmath>
namespace attn_body {
using bf16=__hip_bfloat16;
using bf16x8=__attribute__((ext_vector_type(8)))short;
using s16x4=__attribute__((ext_vector_type(4)))short;
using f32x16=__attribute__((ext_vector_type(16)))float;
using u32x4=__attribute__((ext_vector_type(4)))unsigned;
constexpr int D=64,QP=1024,KVP=128;
constexpr int NW=8,QBLK=32,QB=QBLK*NW,KVBLK=64;
__device__ __forceinline__ int crow(int r,int hi){return (r&3)+8*(r>>2)+4*hi;}
#define SBAR() __builtin_amdgcn_sched_barrier(0)
constexpr int NSLOT=3, SLOTB=8192;
constexpr int LDS_K=0, LDS_V=NSLOT*SLOTB, LDS_WS=2*NSLOT*SLOTB, LDS_OST=LDS_WS+NW*64*4, LDS_BYTES=LDS_OST+NW*4096;
constexpr float C2=0.125f*1.4426950408889634f;
__device__ __forceinline__ void glds16(const void*gsrc,unsigned lds_dst){unsigned keep;
  asm volatile("s_mov_b32 %0, m0\n\ts_mov_b32 m0, %2\n\ts_nop 0\n\tglobal_load_lds_dwordx4 %1, off\n\ts_mov_b32 m0, %0":"=&s"(keep):"v"(gsrc),"s"(lds_dst):"memory");}
__device__ __forceinline__ float max3f(float a,float b,float c){float r;asm("v_max3_f32 %0, %1, %2, %3":"=v"(r):"v"(a),"v"(b),"v"(c));return r;}
__device__ __forceinline__ float max2f(float a,float b){float r;asm("v_max_f32_e32 %0, %1, %2":"=v"(r):"v"(a),"v"(b));return r;}
__device__ __forceinline__ float fadd_s(float a,float b){float r;asm("v_add_f32_e32 %0, %1, %2":"=v"(r):"v"(a),"v"(b));return r;}
__device__ __forceinline__ float fsub_s(float a,float b){float r;asm("v_sub_f32_e32 %0, %1, %2":"=v"(r):"v"(a),"v"(b));return r;}
typedef float f32x2_t __attribute__((ext_vector_type(2))); typedef __bf16 bf16x2_t __attribute__((ext_vector_type(2)));
__device__ __forceinline__ unsigned cvtpk_s(float lo,float hi){f32x2_t v={lo,hi};bf16x2_t b=__builtin_convertvector(v,bf16x2_t);return __builtin_bit_cast(unsigned,b);}
#define WAIT_BAR(N) asm volatile("s_waitcnt vmcnt(" #N ") lgkmcnt(0)\n\ts_barrier":::"memory")

__device__ __forceinline__ void qkt(f32x16&p0,f32x16&p1,const char*Kslot,const bf16x8*qr,const f32x16&negm,int r32,int hi){
  const char*kb=Kslot+hi*1024+r32*16;
  #pragma unroll
  for(int d0=0;d0<4;++d0){
    const bf16x8 b0=*reinterpret_cast<const bf16x8*>(kb+d0*2048);
    const bf16x8 b1=*reinterpret_cast<const bf16x8*>(kb+d0*2048+512);
    if(d0==0){p0=__builtin_amdgcn_mfma_f32_32x32x16_bf16(b0,qr[0],negm,0,0,0);p1=__builtin_amdgcn_mfma_f32_32x32x16_bf16(b1,qr[0],negm,0,0,0);}
    else{p0=__builtin_amdgcn_mfma_f32_32x32x16_bf16(b0,qr[d0],p0,0,0,0);p1=__builtin_amdgcn_mfma_f32_32x32x16_bf16(b1,qr[d0],p1,0,0,0);}}
}
typedef __attribute__((address_space(3))) const char* lds_cptr;
typedef short v4i16_t __attribute__((ext_vector_type(4)));
__device__ __forceinline__ void kload8(bf16x8*kf,lds_cptr kp){
  kf[0]=*(const __attribute__((address_space(3))) bf16x8*)(kp);      kf[1]=*(const __attribute__((address_space(3))) bf16x8*)(kp+512);
  kf[2]=*(const __attribute__((address_space(3))) bf16x8*)(kp+2048); kf[3]=*(const __attribute__((address_space(3))) bf16x8*)(kp+2560);
  kf[4]=*(const __attribute__((address_space(3))) bf16x8*)(kp+4096); kf[5]=*(const __attribute__((address_space(3))) bf16x8*)(kp+4608);
  kf[6]=*(const __attribute__((address_space(3))) bf16x8*)(kp+6144); kf[7]=*(const __attribute__((address_space(3))) bf16x8*)(kp+6656);
}
__device__ __forceinline__ void kload2(bf16x8*kf,lds_cptr kp,int j){ kf[2*j]=*(const __attribute__((address_space(3))) bf16x8*)(kp+j*2048); kf[2*j+1]=*(const __attribute__((address_space(3))) bf16x8*)(kp+j*2048+512); }
__device__ __forceinline__ s16x4 vtr(lds_cptr p){ return __builtin_bit_cast(s16x4,__builtin_amdgcn_ds_read_tr16_b64_v4i16((__attribute__((address_space(3))) v4i16_t*)p)); }
__device__ __forceinline__ float rowmax(const f32x16&p0,const f32x16&p1){
  float a=max3f(p0[0],p0[1],p1[0]),b=max3f(p0[2],p0[3],p1[1]);a=max3f(a,p1[2],p1[3]);
  #pragma unroll
  for(int r=4;r<16;r+=4){a=max3f(a,p0[r],p0[r+1]);b=max3f(b,p0[r+2],p0[r+3]);a=max3f(a,p1[r],p1[r+1]);b=max3f(b,p1[r+2],p1[r+3]);}
  const float m=max2f(a,b);
  auto rr=__builtin_amdgcn_permlane32_swap(__float_as_uint(m),__float_as_uint(m),false,false);
  return max2f(__uint_as_float(rr[0]),__uint_as_float(rr[1]));
}
__device__ __forceinline__ void pv(f32x16*o,int vb,bf16x8 pa0,bf16x8 pa1,bf16x8 pa2,bf16x8 pa3){
  #pragma unroll
  for(int d0=0;d0<2;++d0){s16x4 lo[4],hi[4];
    #pragma unroll
    for(int ks=0;ks<4;++ks){
      asm volatile("ds_read_b64_tr_b16 %0,%1 offset:%c2":"=&v"(lo[ks]):"v"(vb),"i"(d0*4096+ks*1024):"memory");
      asm volatile("ds_read_b64_tr_b16 %0,%1 offset:%c2":"=&v"(hi[ks]):"v"(vb),"i"(d0*4096+ks*1024+512):"memory");}
    asm volatile("s_waitcnt lgkmcnt(0)":::"memory");SBAR();
    #define PK(k) (bf16x8){lo[k][0],lo[k][1],lo[k][2],lo[k][3],hi[k][0],hi[k][1],hi[k][2],hi[k][3]}
    o[d0]=__builtin_amdgcn_mfma_f32_32x32x16_bf16(pa0,PK(0),o[d0],0,0,0);
    o[d0]=__builtin_amdgcn_mfma_f32_32x32x16_bf16(pa1,PK(1),o[d0],0,0,0);
    o[d0]=__builtin_amdgcn_mfma_f32_32x32x16_bf16(pa2,PK(2),o[d0],0,0,0);
    o[d0]=__builtin_amdgcn_mfma_f32_32x32x16_bf16(pa3,PK(3),o[d0],0,0,0);
    #undef PK
  }
}

#ifndef ATTN_STORE16
#define ATTN_STORE16(p,v) (*(u32x4*)(p)=(v))
#endif
template<int THRL> __device__ __forceinline__ void attn_unit(bf16*Qu,bf16*Ou,const bf16*__restrict__ Kh,const bf16*__restrict__ Vh,const int NT,char*shm){
  const int tid=opaque_tid(),lane=tid&63,r32=lane&31,hi=lane>>5; const int wid=__builtin_amdgcn_readfirstlane(tid>>6);
  const bf16*Qw=Qu+(long)(wid*QBLK)*QP;
  const unsigned lds0=(unsigned)(uintptr_t)shm;
  float*wsf=(float*)(shm+LDS_WS)+wid*64;
  const bf16*ksrc=Kh+(long)lane*KVP+wid*8;
  const bf16*vsrc=Vh+(long)(16*(wid&3)+(lane>>2))*KVP+(wid>>2)*32+(lane&3)*8;
  const unsigned kdst=lds0+LDS_K+wid*1024, vdst=lds0+LDS_V+wid*1024;
  #define DMA_K(t,slot) glds16(ksrc+(long)(t)*KVBLK*KVP,(unsigned)__builtin_amdgcn_readfirstlane(kdst+(slot)))
  #define DMA_V(t,slot) glds16(vsrc+(long)(t)*KVBLK*KVP,(unsigned)__builtin_amdgcn_readfirstlane(vdst+(slot)))
  const int vb0=(int)(lds0+LDS_V)+((lane>>4)&1)*32+(lane&3)*8+(4*hi+((lane&15)>>2))*64;
  const char*Kbase=shm+LDS_K; bf16x8 kf[8];
  const lds_cptr shm3=(lds_cptr)shm; const lds_cptr kp0=shm3+LDS_K+hi*1024+r32*16; const lds_cptr vp0=shm3+LDS_V+((lane>>4)&1)*32+(lane&3)*8+(4*hi+((lane&15)>>2))*64;
  DMA_K(0,0);DMA_V(0,0);DMA_K(1,SLOTB);
  bf16x8 qr[4];
  #pragma unroll
  for(int d0=0;d0<4;++d0)qr[d0]=*reinterpret_cast<const bf16x8*>(&Qw[(long)r32*QP+d0*16+hi*8]);
  float mhat=0.f,l_reg=0.f;f32x16 o[2];o[0]=f32x16{};o[1]=f32x16{};f32x16 negm=f32x16{};asm volatile("":"+v"(negm));
  #define CMASK(P0,P1,t) do{}while(0)
  bool resc=false;
  #define START(P0,P1) do{ const float rm=rowmax(P0,P1); resc=false; \
    { const float dl=rm; mhat=fadd_s(mhat,dl); \
      _Pragma("unroll") for(int r=0;r<16;++r){P0[r]=fsub_s(P0[r],dl);P1[r]=fsub_s(P1[r],dl);} \
      _Pragma("unroll") for(int r=0;r<16;++r)negm[r]=-mhat; asm volatile("":"+v"(negm)); } \
    _Pragma("unroll") for(int r=0;r<16;++r)P0[r]=__builtin_amdgcn_exp2f(P0[r]); }while(0)
  #define RESC() do{ if(resc){ asm volatile("s_waitcnt lgkmcnt(0)":::"memory"); \
      _Pragma("unroll") for(int d_=0;d_<2;++d_) _Pragma("unroll") for(int r=0;r<16;++r)o[d_][r]*=wsf[crow(r,hi)]; } }while(0)
  f32x16 pA0,pA1,pB0,pB1;
  int sl_prev=0,sl_cur=0,sl_next=SLOTB;
  #define ROT() do{sl_prev=sl_cur;sl_cur=sl_next;sl_next=(sl_next==(NSLOT-1)*SLOTB)?0:sl_next+SLOTB;}while(0)
  DMA_K(2,2*SLOTB);
  WAIT_BAR(3);
  qkt(pA0,pA1,Kbase,qr,negm,r32,hi);asm volatile("s_nop 15\n\ts_nop 7":"+v"(pA0),"+v"(pA1));CMASK(pA0,pA1,0);
  START(pA0,pA1);
  _Pragma("unroll") for(int r=0;r<16;++r)pA1[r]=__builtin_amdgcn_exp2f(pA1[r]);
  WAIT_BAR(0);
  DMA_K(3,0);DMA_V(1,SLOTB);
  ROT();
  kload8(kf,kp0+sl_cur);
  WAIT_BAR(2);
  s16x4 vlo[8],vhi[8]; u32x4 pw0,pw1,pw2,pw3;
  #define PKW(P,B) cvtpk_s(P[B],P[B+1])
  #define PAF(k) __builtin_bit_cast(bf16x8,pw##k)
  #define VFR(i) (bf16x8){vlo[i][0],vlo[i][1],vlo[i][2],vlo[i][3],vhi[i][0],vhi[i][1],vhi[i][2],vhi[i][3]}
  #define PIN(x) asm volatile("":"+v"(x))
  #define MX3(a,b,c) __builtin_fmaxf(__builtin_fmaxf((a),(b)),(c))
  #define GAPA(MF,A0,A1,A2,A3,W0,W1,PW) do{ MF; sacc+=A0; sacc+=A1; sacc+=A2; sacc+=A3; PIN(sacc); W0; W1; PIN(PW); SBAR(); }while(0)
  #define EX(v) __builtin_amdgcn_exp2f(v)
  #define GAPB(MF,X,B) do{ MF; X[B]=EX(X[B]); X[B+1]=EX(X[B+1]); X[B+2]=EX(X[B+2]); X[B+3]=EX(X[B+3]); PIN(X); SBAR(); }while(0)
  #define VRD(i) do{ vlo[i]=vtr(vp_+(((i)>>2)*4096+((i)&3)*1024)); vhi[i]=vtr(vp_+(((i)>>2)*4096+((i)&3)*1024+512)); }while(0)
  #define KRD(G,j) do{ if(G){ kload2(kf,kp0+sl_next,j); SBAR(); } }while(0)
  #define STEP(C0,C1,P0,P1,t,GK,GV,GL) do{ SBAR(); \
    const lds_cptr vp_=vp0+sl_prev; \
    VRD(0); SBAR(); float sacc=(P0[0]+P0[1]); \
    GAPA(C0=__builtin_amdgcn_mfma_f32_32x32x16_bf16(kf[0],qr[0],negm,0,0,0), P0[2],P0[3],P0[4],P0[5],     pw0[0]=PKW(P0,0), pw0[1]=PKW(P0,2), pw0); \
    VRD(4); SBAR(); GAPA(C1=__builtin_amdgcn_mfma_f32_32x32x16_bf16(kf[1],qr[0],negm,0,0,0), P0[6],P0[7],P0[8],P0[9],     pw0[2]=PKW(P0,4), pw0[3]=PKW(P0,6), pw0); \
    VRD(1); SBAR(); GAPA(C0=__builtin_amdgcn_mfma_f32_32x32x16_bf16(kf[2],qr[1],C0,0,0,0),   P0[10],P0[11],P0[12],P0[13], pw1[0]=PKW(P0,8), pw1[1]=PKW(P0,10), pw1); \
    VRD(5); SBAR(); GAPA(C1=__builtin_amdgcn_mfma_f32_32x32x16_bf16(kf[3],qr[1],C1,0,0,0),   P0[14],P0[15],P1[0],P1[1],   pw1[2]=PKW(P0,12),pw1[3]=PKW(P0,14), pw1); \
    VRD(2); SBAR(); GAPA(C0=__builtin_amdgcn_mfma_f32_32x32x16_bf16(kf[4],qr[2],C0,0,0,0),   P1[2],P1[3],P1[4],P1[5],     pw2[0]=PKW(P1,0), pw2[1]=PKW(P1,2), pw2); \
    VRD(6); SBAR(); GAPA(C1=__builtin_amdgcn_mfma_f32_32x32x16_bf16(kf[5],qr[2],C1,0,0,0),   P1[6],P1[7],P1[8],P1[9],     pw2[2]=PKW(P1,4), pw2[3]=PKW(P1,6), pw2); \
    VRD(3); SBAR(); GAPA(C0=__builtin_amdgcn_mfma_f32_32x32x16_bf16(kf[6],qr[3],C0,0,0,0),   P1[10],P1[11],P1[12],P1[13], pw3[0]=PKW(P1,8), pw3[1]=PKW(P1,10), pw3); \
    VRD(7); SBAR(); GAPA(C1=__builtin_amdgcn_mfma_f32_32x32x16_bf16(kf[7],qr[3],C1,0,0,0),   P1[14],P1[15],0.f,0.f,       pw3[2]=PKW(P1,12),pw3[3]=PKW(P1,14), pw3); \
    l_reg+=sacc; \
    if(GK){DMA_K((t)+3,sl_cur);} if(GV){DMA_V((t)+1,sl_next);} \
    CMASK(C0,C1,t); \
    { float a=MX3(C0[0],C0[1],C1[0]),b=MX3(C0[2],C0[3],C1[1]); a=MX3(a,C1[2],C1[3]); \
      _Pragma("unroll") for(int r=4;r<16;r+=4){a=MX3(a,C0[r],C0[r+1]);b=MX3(b,C0[r+2],C0[r+3]);a=MX3(a,C1[r],C1[r+1]);b=MX3(b,C1[r+2],C1[r+3]);} \
      float rm=__builtin_fmaxf(a,b); { auto rr=__builtin_amdgcn_permlane32_swap(__float_as_uint(rm),__float_as_uint(rm),false,false); rm=__builtin_fmaxf(__uint_as_float(rr[0]),__uint_as_float(rr[1])); } \
      resc=false; \
      if(__builtin_expect(__any(rm>(float)THRL),0)){ const float dl=__builtin_fmaxf(rm,0.f); mhat+=dl; \
        _Pragma("unroll") for(int r=0;r<16;++r){C0[r]-=dl;C1[r]-=dl;} \
        _Pragma("unroll") for(int r=0;r<16;++r)negm[r]=-mhat; asm volatile("":"+v"(negm)); \
        const float f=__builtin_amdgcn_exp2f(-dl); l_reg*=f; if(hi==0)wsf[r32]=f; resc=true; } } \
    SBAR(); \
    GAPB(o[0]=__builtin_amdgcn_mfma_f32_32x32x16_bf16(PAF(0),VFR(0),o[0],0,0,0), C0,0); \
    GAPB(o[1]=__builtin_amdgcn_mfma_f32_32x32x16_bf16(PAF(0),VFR(4),o[1],0,0,0), C0,4); \
    KRD(GL,0); GAPB(o[0]=__builtin_amdgcn_mfma_f32_32x32x16_bf16(PAF(1),VFR(1),o[0],0,0,0), C0,8); \
    KRD(GL,1); GAPB(o[1]=__builtin_amdgcn_mfma_f32_32x32x16_bf16(PAF(1),VFR(5),o[1],0,0,0), C0,12); \
    KRD(GL,2); GAPB(o[0]=__builtin_amdgcn_mfma_f32_32x32x16_bf16(PAF(2),VFR(2),o[0],0,0,0), C1,0); \
    KRD(GL,3); GAPB(o[1]=__builtin_amdgcn_mfma_f32_32x32x16_bf16(PAF(2),VFR(6),o[1],0,0,0), C1,4); \
    GAPB(o[0]=__builtin_amdgcn_mfma_f32_32x32x16_bf16(PAF(3),VFR(3),o[0],0,0,0), C1,8); \
    GAPB(o[1]=__builtin_amdgcn_mfma_f32_32x32x16_bf16(PAF(3),VFR(7),o[1],0,0,0), C1,12); \
    }while(0)
  int t=1;
  #undef CMASK
  #define CMASK(P0,P1,t) do{}while(0)
  for(;t+5<NT;t+=2){
    STEP(pB0,pB1,pA0,pA1,t,true,true,true);     WAIT_BAR(2); RESC(); ROT();
    STEP(pA0,pA1,pB0,pB1,t+1,true,true,true);   WAIT_BAR(2); RESC(); ROT();
  }
  #undef CMASK
  #define CMASK(P0,P1,t) do{}while(0)
  #define ENDW(tt) do{ if((tt)+3<NT){WAIT_BAR(2);} else if((tt)+2<NT){WAIT_BAR(1);} else {WAIT_BAR(0);} }while(0)
  for(;t+1<NT;t+=2){
    STEP(pB0,pB1,pA0,pA1,t,(t+3<NT),(t+1<NT),(t+1<NT));       ENDW(t);   RESC(); ROT();
    STEP(pA0,pA1,pB0,pB1,t+1,(t+4<NT),(t+2<NT),(t+2<NT));     ENDW(t+1); RESC(); ROT();
  }
  STEP(pB0,pB1,pA0,pA1,NT-1,false,false,false); RESC();
  { float sacc=pB0[0]+pB0[1]; _Pragma("unroll") for(int r=2;r<16;++r)sacc+=pB0[r]; _Pragma("unroll") for(int r=0;r<16;++r)sacc+=pB1[r]; l_reg+=sacc;
    pw0=(u32x4){PKW(pB0,0),PKW(pB0,2),PKW(pB0,4),PKW(pB0,6)};pw1=(u32x4){PKW(pB0,8),PKW(pB0,10),PKW(pB0,12),PKW(pB0,14)};pw2=(u32x4){PKW(pB1,0),PKW(pB1,2),PKW(pB1,4),PKW(pB1,6)};pw3=(u32x4){PKW(pB1,8),PKW(pB1,10),PKW(pB1,12),PKW(pB1,14)};
    SBAR(); pv(o,vb0+sl_cur,PAF(0),PAF(1),PAF(2),PAF(3)); }
  #undef PKW
  #undef PAF
  #undef VFR
  #undef PIN
  #undef MX3
  #undef GAPA
  #undef GAPB
  #undef EX
  #undef VRD
  #undef KRD
  #undef STEP
  #undef ENDW
  {auto rr=__builtin_amdgcn_permlane32_swap(__float_as_uint(l_reg),__float_as_uint(l_reg),false,false);l_reg=__uint_as_float(rr[0])+__uint_as_float(rr[1]);}
  if(hi==0)wsf[32+r32]=l_reg;asm volatile("s_waitcnt lgkmcnt(0)":::"memory");
  float rli[16];
  #pragma unroll
  for(int r=0;r<16;++r)rli[r]=__builtin_amdgcn_rcpf(wsf[32+crow(r,hi)]);
  bf16*Ow=Ou+(long)(wid*QBLK)*QP;
  { bf16*stg=(bf16*)(shm+LDS_OST)+wid*2048;
    #pragma unroll
    for(int r=0;r<16;++r){const int orow=crow(r,hi);
      #pragma unroll
      for(int d0=0;d0<2;++d0)stg[orow*64+d0*32+r32]=__float2bfloat16(o[d0][r]*rli[r]);}
    asm volatile("s_waitcnt lgkmcnt(0)":::"memory");
    #pragma unroll
    for(int i=0;i<4;++i){const int row=i*8+(lane>>3),ch=lane&7; const u32x4 v=*(const u32x4*)(stg+row*64+ch*8); ATTN_STORE16(Ow+(long)row*QP+ch*8,v);} }
  asm volatile("s_waitcnt lgkmcnt(0)\n\ts_barrier":::"memory");
  #undef DMA_K
  #undef DMA_V
  #undef CMASK
  #undef START
  #undef RESC
  #undef ROT
}
constexpr int ATTN_LDS_BYTES=LDS_BYTES;
#undef SBAR
#undef WAIT_BAR
}
#define LAS __attribute__((address_space(3)))
typedef unsigned short bf16;
typedef unsigned v4u __attribute__((ext_vector_type(4)));
typedef unsigned v2u __attribute__((ext_vector_type(2)));
typedef float f32x4 __attribute__((ext_vector_type(4)));
typedef short bf16x8 __attribute__((ext_vector_type(8)));
typedef short bf16x4 __attribute__((ext_vector_type(4)));

constexpr int NB = 8, TL = 4096, TCX = 256, DM = 1024, DEPTH = 4, NMOD = 6;
constexpr int ML = NB * TL, MC = NB * TCX, MT = ML + MC;
constexpr int NINP = 3072, NIN = 2832;
constexpr int FF = 4096, KVLEN = TCX + TL;
constexpr float EPS = 1e-6f;
constexpr size_t MiB = 1u << 20;
constexpr size_t WS_MOD = 64 * 1024;
constexpr size_t WS_WIN = 2 * MiB, WS_WOUT = 8 * MiB, WS_W1 = 10 * MiB, WS_W2 = 18 * MiB;
constexpr size_t WS_X = 26 * MiB;
constexpr size_t WS_XN = 162 * MiB;
constexpr size_t WS_HB = WS_XN + 34 * MiB;
constexpr size_t WS_AO = 230 * MiB;
constexpr size_t WS_PM = 298 * MiB;
constexpr size_t WS_K = 434 * MiB, WS_V = 443 * MiB;
constexpr size_t WS_G = 452 * MiB;
constexpr size_t WS_H = 230 * MiB;
constexpr size_t WS_GA = 456 * MiB, WS_BP = 458 * MiB, WS_CH = 462 * MiB;
constexpr size_t WS_END = 502 * MiB;
constexpr int LDS_BYTES = 163840, TAB_OFF = 163840 - 256;
__device__ __forceinline__ unsigned long long rd_ptr(const unsigned char* lds, int k) {
    const LAS unsigned* t = (const LAS unsigned*)((const LAS unsigned char*)lds + TAB_OFF) + 2 * k; unsigned lo = t[0], hi = t[1];
    lo = __builtin_amdgcn_readfirstlane(lo); hi = __builtin_amdgcn_readfirstlane(hi); return ((unsigned long long)hi << 32) | lo; }

__device__ __forceinline__ unsigned f2bf(float f) { unsigned u = __builtin_bit_cast(unsigned, f); return (u + 0x7fffu + ((u >> 16) & 1u)) >> 16; }
__device__ __forceinline__ unsigned pk2(float lo, float hi) { return pg8::cvt_pk_bf16(lo, hi); }
__device__ __forceinline__ float bflo(unsigned w) { return __builtin_bit_cast(float, w << 16); }
__device__ __forceinline__ float bfhi(unsigned w) { return __builtin_bit_cast(float, w & 0xffff0000u); }
__device__ __forceinline__ float wave_sum(float v) {
#pragma unroll
    for (int o = 1; o < 64; o <<= 1) v += __shfl_xor(v, o);
    return v;
}
__device__ __forceinline__ float sigmoidf_(float x) { return 1.f / (1.f + __expf(-x)); }
__device__ __forceinline__ float siluf_(float x) { return x / (1.f + __expf(-x)); }
__device__ __forceinline__ float logsigmoidf_(float x) { return x < 0.f ? x - log1pf(__expf(x)) : -log1pf(__expf(-x)); }

struct Args { const float* in[18]; float* out; unsigned char* ws; };

__device__ __forceinline__ void transpose_item(const float* W, int K, int N, int NBLK, bf16* WT, float* scr, int item, int lane) {
    const int kb = item / NBLK, nb = item % NBLK, k0 = 64 * kb, n0 = 32 * nb; const int n = n0 + (lane & 31);
#pragma unroll 16
    for (int i = 0; i < 32; ++i) { const int kk = 2 * i + (lane >> 5); scr[kk * 33 + (lane & 31)] = (n < N) ? W[(size_t)(k0 + kk) * N + n] : 0.f; }
    asm volatile("s_waitcnt lgkmcnt(0)" ::: "memory");
    const int c = lane & 7;
#pragma unroll
    for (int j = 0; j < 4; ++j) { const int nn = (lane >> 3) + 8 * j; const float* s = scr + (8 * c) * 33 + nn;
        v4u o; o.x = pk2(s[0 * 33], s[1 * 33]); o.y = pk2(s[2 * 33], s[3 * 33]); o.z = pk2(s[4 * 33], s[5 * 33]); o.w = pk2(s[6 * 33], s[7 * 33]);
        *(v4u*)(WT + (size_t)(n0 + nn) * K + k0 + 8 * c) = o; }
    asm volatile("s_waitcnt lgkmcnt(0)" ::: "memory");
}

template <bool BF> __device__ __forceinline__ f32x4 ldx4(const void* row, int i) {
    if (BF) { const v2u w = ((const v2u*)row)[i]; return (f32x4){bflo(w.x), bfhi(w.x), bflo(w.y), bfhi(w.y)}; }
    else return ((const f32x4*)row)[i];
}
template <bool BF> __device__ __forceinline__ void modulate_row(const void* xrow, bf16* orow, const float* gain, const float* shift, const float* scale, int lane) {
    f32x4 v[4]; float s = 0.f;
#pragma unroll
    for (int j = 0; j < 4; ++j) { v[j] = ldx4<BF>(xrow, lane + 64 * j); s += (v[j].x * v[j].x + v[j].y * v[j].y) + (v[j].z * v[j].z + v[j].w * v[j].w); }
    const float r = rsqrtf(wave_sum(s) * (1.f / DM) + EPS);
    unsigned long long* o8 = (unsigned long long*)orow + lane;
#pragma unroll
    for (int j = 0; j < 4; ++j) { const int c = 4 * lane + 256 * j;
        const f32x4 g = *(const f32x4*)(gain + c), sh = *(const f32x4*)(shift + c), sc = *(const f32x4*)(scale + c);
        const f32x4 y = v[j] * r * g * (sc + 1.f) + sh;
        o8[64 * j] = (unsigned long long)pk2(y.x, y.y) | ((unsigned long long)pk2(y.z, y.w) << 32); }
}
template <bool BF> __device__ __forceinline__ void modulate_row2(const void* x0, bf16* o0, const float* sh0, const float* sc0, const void* x1, bf16* o1, const float* sh1, const float* sc1, const float* gain, int lane) {
    f32x4 v0[4], v1[4]; float s0 = 0.f, s1 = 0.f;
#pragma unroll
    for (int j = 0; j < 4; ++j) { v0[j] = ldx4<BF>(x0, lane + 64 * j); v1[j] = ldx4<BF>(x1, lane + 64 * j); }
#pragma unroll
    for (int j = 0; j < 4; ++j) { s0 += (v0[j].x * v0[j].x + v0[j].y * v0[j].y) + (v0[j].z * v0[j].z + v0[j].w * v0[j].w); s1 += (v1[j].x * v1[j].x + v1[j].y * v1[j].y) + (v1[j].z * v1[j].z + v1[j].w * v1[j].w); }
#pragma unroll
    for (int o = 1; o < 64; o <<= 1) { s0 += __shfl_xor(s0, o); s1 += __shfl_xor(s1, o); }
    const float r0 = rsqrtf(s0 * (1.f / DM) + EPS), r1 = rsqrtf(s1 * (1.f / DM) + EPS);
    unsigned long long* p0 = (unsigned long long*)o0 + lane; unsigned long long* p1 = (unsigned long long*)o1 + lane;
#pragma unroll
    for (int j = 0; j < 4; ++j) { const int c = 4 * lane + 256 * j;
        const f32x4 g = *(const f32x4*)(gain + c);
        const f32x4 y0 = v0[j] * r0 * g * (*(const f32x4*)(sc0 + c) + 1.f) + *(const f32x4*)(sh0 + c);
        const f32x4 y1 = v1[j] * r1 * g * (*(const f32x4*)(sc1 + c) + 1.f) + *(const f32x4*)(sh1 + c);
        p0[64 * j] = (unsigned long long)pk2(y0.x, y0.y) | ((unsigned long long)pk2(y0.z, y0.w) << 32);
        p1[64 * j] = (unsigned long long)pk2(y1.x, y1.y) | ((unsigned long long)pk2(y1.z, y1.w) << 32); }
}
template <bool BF> __device__ __forceinline__ void modulate_rows4(const void* xbase, bf16* obase, int row, int st, const float* modbase  , int shoff, int scoff, const float* gain, int lane) {
    f32x4 v[4][4]; float ss[4];
#pragma unroll
    for (int q = 0; q < 4; ++q) { const void* xr = BF ? (const void*)((const bf16*)xbase + (size_t)(row + q * st) * 1024) : (const void*)((const float*)xbase + (size_t)(row + q * st) * 1024);
#pragma unroll
        for (int j = 0; j < 4; ++j) v[q][j] = ldx4<BF>(xr, lane + 64 * j); }
#pragma unroll
    for (int q = 0; q < 4; ++q) { float a = 0.f;
#pragma unroll
        for (int j = 0; j < 4; ++j) a += (v[q][j].x * v[q][j].x + v[q][j].y * v[q][j].y) + (v[q][j].z * v[q][j].z + v[q][j].w * v[q][j].w);
        ss[q] = a; }
#pragma unroll
    for (int o = 1; o < 64; o <<= 1) {
#pragma unroll
        for (int q = 0; q < 4; ++q) ss[q] += __shfl_xor(ss[q], o); }
#pragma unroll
    for (int q = 0; q < 4; ++q) { const int r_ = row + q * st; const float r = rsqrtf(ss[q] * (1.f / DM) + EPS);
        const float* mp = modbase + (size_t)(r_ >> 12) * 6144;
        unsigned long long* p = (unsigned long long*)(obase + (size_t)r_ * 1024) + lane;
#pragma unroll
        for (int j = 0; j < 4; ++j) { const int c = 4 * lane + 256 * j;
            const f32x4 y = v[q][j] * r * *(const f32x4*)(gain + c) * (*(const f32x4*)(mp + scoff + c) + 1.f) + *(const f32x4*)(mp + shoff + c);
            p[64 * j] = (unsigned long long)pk2(y.x, y.y) | ((unsigned long long)pk2(y.z, y.w) << 32); } }
}
template <bool BF> __device__ __forceinline__ void modulate_row_part(const void* xrow, bf16* xout, const bf16* part  , const float* gate, bf16* orow, const float* gain, const float* shift, const float* scale, int lane) {
    f32x4 v[4]; float s = 0.f;
#pragma unroll
    for (int j = 0; j < 4; ++j) { f32x4 p = (f32x4){0.f, 0.f, 0.f, 0.f};
#pragma unroll
        for (int sl = 0; sl < 8; ++sl) p += ldx4<true>(part + (size_t)sl * 2048 * 1024, lane + 64 * j);
        v[j] = ldx4<BF>(xrow, lane + 64 * j) + *(const f32x4*)(gate + 4 * lane + 256 * j) * p;
        ((unsigned long long*)xout + lane)[64 * j] = (unsigned long long)pk2(v[j].x, v[j].y) | ((unsigned long long)pk2(v[j].z, v[j].w) << 32);
        s += (v[j].x * v[j].x + v[j].y * v[j].y) + (v[j].z * v[j].z + v[j].w * v[j].w); }
    const float r = rsqrtf(wave_sum(s) * (1.f / DM) + EPS);
    unsigned long long* o8 = (unsigned long long*)orow + lane;
#pragma unroll
    for (int j = 0; j < 4; ++j) { const int c = 4 * lane + 256 * j;
        const f32x4 g = *(const f32x4*)(gain + c), sh = *(const f32x4*)(shift + c), sc = *(const f32x4*)(scale + c);
        const f32x4 y = v[j] * r * g * (sc + 1.f) + sh;
        o8[64 * j] = (unsigned long long)pk2(y.x, y.y) | ((unsigned long long)pk2(y.z, y.w) << 32); }
}

#define XB_TMO      128
#define XB_XCNT(j)  (256  + 64 * (j))
#define XB_XSUB(j)  (1280 + 64 * (j))
#define XB_XGEN(j)  (2304 + 64 * (j))
#define XB_TOP      3328
#define XB_TOPGEN   3392
#define XCD_BAR_WORDS 3456
#define XB_SPIN_CAP (1u << 18)

__device__ __forceinline__ unsigned xb_ld(unsigned* p)              { return __hip_atomic_load(p, __ATOMIC_RELAXED, __HIP_MEMORY_SCOPE_AGENT); }
__device__ __forceinline__ unsigned xb_add(unsigned* p, unsigned v) { return __hip_atomic_fetch_add(p, v, __ATOMIC_RELAXED, __HIP_MEMORY_SCOPE_AGENT); }
__device__ __forceinline__ unsigned xb_xcc_id() { return (unsigned)__builtin_amdgcn_s_getreg((3 << 11) | 20) & 0xFu; }
#define XB_SPIN(cond, bar) do { unsigned _sp = 0; while (cond) { __builtin_amdgcn_s_sleep(1); \
    if ((++_sp & 255u) == 0u) { if (xb_ld(&(bar)[XB_TMO])) break; if (_sp > XB_SPIN_CAP) { atomicAdd(&(bar)[XB_TMO], 1u); break; } } } } while (0)

struct XcdBarrier {
    unsigned* bar; unsigned x;
    volatile LAS unsigned* st;
};

__device__ __forceinline__ XcdBarrier xcd_barrier_post(unsigned* bar, volatile LAS unsigned* st) {
    XcdBarrier b; b.bar = bar; b.x = xb_xcc_id(); b.st = st;
    if (threadIdx.x == 0) (void)xb_add(&bar[XB_XCNT(b.x)], 1u);
    return b;
}
__device__ __forceinline__ void xcd_barrier_complete(unsigned* bar, unsigned x, unsigned& nloc, unsigned& nx) {
    const unsigned G = gridDim.x * gridDim.y * gridDim.z;
    unsigned sum, cnt, mine, sp = 0u;
    for (;;) {
        sum = 0u; cnt = 0u; mine = 0u;
#pragma unroll
        for (unsigned j = 0; j < 16; ++j) { const unsigned c = xb_ld(&bar[XB_XCNT(j)]); sum += c; cnt += (c > 0u) ? 1u : 0u; mine = (j == x) ? c : mine; }
        if (sum == G) break;
        __builtin_amdgcn_s_sleep(1);
        if ((++sp & 255u) == 0u) { if (xb_ld(&bar[XB_TMO])) break; if (sp > XB_SPIN_CAP) { atomicAdd(&bar[XB_TMO], 1u); break; } }
    }
    nloc = mine > 0u ? mine : 1u; nx = cnt > 0u ? cnt : 1u;
}

__device__ __forceinline__ void xcd_barrier(const XcdBarrier& b) {
    asm volatile("s_waitcnt vmcnt(0)" ::: "memory");
    __syncthreads();
    if (threadIdx.x == 0) {
        unsigned* bar = b.bar;
        __builtin_amdgcn_s_waitcnt(0);
        unsigned nloc = b.st[0], nx = b.st[1];
        if (nloc == 0u) { xcd_barrier_complete(bar, b.x, nloc, nx); b.st[0] = nloc; b.st[1] = nx; }
        const unsigned old = xb_add(&bar[XB_XSUB(b.x)], 1u);
        const unsigned gen = old / nloc;
        if (old + 1u == (gen + 1u) * nloc) {
            __builtin_amdgcn_fence(__ATOMIC_RELEASE, "agent");
            asm volatile("s_waitcnt vmcnt(0)" ::: "memory");
            const unsigned og = xb_add(&bar[XB_TOP], 1u);
            const unsigned tg = og / nx;
            if (og + 1u == (tg + 1u) * nx) xb_add(&bar[XB_TOPGEN], 1u);
            else XB_SPIN(xb_ld(&bar[XB_TOPGEN]) == tg, bar);
            __builtin_amdgcn_fence(__ATOMIC_ACQUIRE, "agent");
            xb_add(&bar[XB_XGEN(b.x)], 1u);
            asm volatile("s_waitcnt vmcnt(0)" ::: "memory");
        } else {
            XB_SPIN(xb_ld(&bar[XB_XGEN(b.x)]) == gen, bar);
            __builtin_amdgcn_fence(__ATOMIC_ACQUIRE, "agent");
            asm volatile("s_waitcnt vmcnt(0)" ::: "memory");
        }
    }
    __syncthreads();
}
__device__ __forceinline__ void modulate_row2(const float* x0, bf16* o0, const float* sh0, const float* sc0, const float* x1, bf16* o1, const float* sh1, const float* sc1, const float* gain, int lane) {
    const f32x4* xr0 = (const f32x4*)x0 + lane; const f32x4* xr1 = (const f32x4*)x1 + lane;
    f32x4 v0[4], v1[4]; float s0 = 0.f, s1 = 0.f;
#pragma unroll
    for (int j = 0; j < 4; ++j) { v0[j] = xr0[64 * j]; v1[j] = xr1[64 * j]; }
#pragma unroll
    for (int j = 0; j < 4; ++j) { s0 += (v0[j].x * v0[j].x + v0[j].y * v0[j].y) + (v0[j].z * v0[j].z + v0[j].w * v0[j].w); s1 += (v1[j].x * v1[j].x + v1[j].y * v1[j].y) + (v1[j].z * v1[j].z + v1[j].w * v1[j].w); }
#pragma unroll
    for (int o = 1; o < 64; o <<= 1) { s0 += __shfl_xor(s0, o); s1 += __shfl_xor(s1, o); }
    const float r0 = rsqrtf(s0 * (1.f / DM) + EPS), r1 = rsqrtf(s1 * (1.f / DM) + EPS);
    unsigned long long* p0 = (unsigned long long*)o0 + lane; unsigned long long* p1 = (unsigned long long*)o1 + lane;
#pragma unroll
    for (int j = 0; j < 4; ++j) { const int c = 4 * lane + 256 * j;
        const f32x4 g = *(const f32x4*)(gain + c);
        const f32x4 y0 = v0[j] * r0 * g * (*(const f32x4*)(sc0 + c) + 1.f) + *(const f32x4*)(sh0 + c);
        const f32x4 y1 = v1[j] * r1 * g * (*(const f32x4*)(sc1 + c) + 1.f) + *(const f32x4*)(sh1 + c);
        p0[64 * j] = (unsigned long long)pk2(y0.x, y0.y) | ((unsigned long long)pk2(y0.z, y0.w) << 32);
        p1[64 * j] = (unsigned long long)pk2(y1.x, y1.y) | ((unsigned long long)pk2(y1.z, y1.w) << 32); }
}
__device__ __forceinline__ void modulate_row_part(const float* xrow, float* xout, const float* part  , const float* gate, bf16* orow, const float* gain, const float* shift, const float* scale, int lane) {
    const f32x4* xr = (const f32x4*)xrow + lane;
    f32x4 v[4]; float s = 0.f;
#pragma unroll
    for (int j = 0; j < 4; ++j) { f32x4 p = (f32x4){0.f, 0.f, 0.f, 0.f};
#pragma unroll
        for (int sl = 0; sl < 8; ++sl) p += *((const f32x4*)(part + (size_t)sl * 2048 * 1024) + lane + 64 * j);
        v[j] = xr[64 * j] + *(const f32x4*)(gate + 4 * lane + 256 * j) * p;
        ((f32x4*)xout + lane)[64 * j] = v[j];
        s += (v[j].x * v[j].x + v[j].y * v[j].y) + (v[j].z * v[j].z + v[j].w * v[j].w); }
    const float r = rsqrtf(wave_sum(s) * (1.f / DM) + EPS);
    unsigned long long* o8 = (unsigned long long*)orow + lane;
#pragma unroll
    for (int j = 0; j < 4; ++j) { const int c = 4 * lane + 256 * j;
        const f32x4 g = *(const f32x4*)(gain + c), sh = *(const f32x4*)(shift + c), sc = *(const f32x4*)(scale + c);
        const f32x4 y = v[j] * r * g * (sc + 1.f) + sh;
        o8[64 * j] = (unsigned long long)pk2(y.x, y.y) | ((unsigned long long)pk2(y.z, y.w) << 32); }
}

constexpr int RS = 136;
constexpr int DVS = 64, NMT = DVS / 16;
constexpr int ML_QS = 0, ML_KS = 128 * RS * 2, ML_KT = 2 * 128 * RS * 2, ML_VT = 3 * 128 * RS * 2, ML_CS = ML_VT + DVS * RS * 2, ML_AV = ML_CS + (DVS + 16) * RS * 2, ML_END = ML_AV + 8 * 128 * 4;
static_assert(ML_END <= TAB_OFF, "mLSTM LDS");
#define MFMA16(a, b, c) __builtin_amdgcn_mfma_f32_16x16x32_bf16((a), (b), (c), 0, 0, 0)

__device__ __forceinline__ void mlstm_item(int item, const bf16* PM  , const float* GA, const float* BP, const float* CH, bf16* HF, bf16* HB, char* lds) {
    const int tid = opaque_tid(), lane = tid & 63, wv = tid >> 6, w = __builtin_amdgcn_readfirstlane(tid >> 6);
    const int chain = item >> 1, slice = item & 1, b = chain >> 3, h = (chain >> 1) & 3, dir = chain & 1;
    const int c16 = lane & 15, quad = lane >> 4;
    bf16* QS = (bf16*)(lds + ML_QS); bf16* KS = (bf16*)(lds + ML_KS); bf16* KT = (bf16*)(lds + ML_KT); bf16* VT = (bf16*)(lds + ML_VT); bf16* CS = (bf16*)(lds + ML_CS);
    float* AV = (float*)(lds + ML_AV) + wv * 128;
    bf16* Hout = dir ? HB : HF;
    const int ttv = (wv < 4) ? wv : 11 - wv, tt = __builtin_amdgcn_readfirstlane(ttv);
    const bf16* qs_f = QS + (16 * ttv + c16) * RS + 8 * quad;
    const bf16* cs_f = CS + c16 * RS + 8 * quad;
    const bf16* ks_f = KS + c16 * RS + 8 * quad;
    const bf16* vt4_f = VT + c16 * RS + 4 * quad;
    const bf16* vt8_f = VT + c16 * RS + 8 * quad;
    const bf16* kt_f = KT + (16 * wv + c16) * RS + 8 * quad;
    bf16* qs_w = QS + (2 * lane) * RS + 16 * wv;
    bf16* ks_w = KS + (2 * lane) * RS + 16 * wv;
    bf16* kt_w = KT + (16 * wv) * RS + 2 * lane;
    bf16* vt_w = VT + (8 * wv) * RS + 2 * lane;
    bf16* cs_w = CS + (4 * quad) * RS + 16 * wv + c16;
    const float* av_r = AV + 4 * quad;
    const int tl = 16 * ttv + c16;
    const float2* ga = (const float2*)(GA + (size_t)chain * KVLEN);
    const float2* bp = (const float2*)BP + (size_t)chain * KVLEN;
    const float2* ch = (const float2*)CH + chain * 34;
    for (int i = tid; i < (DVS + 16) * RS / 2; i += 512) ((unsigned*)CS)[i] = 0u;
    f32x4 Cacc[NMT + 1];
#pragma unroll
    for (int mt = 0; mt <= NMT; ++mt) Cacc[mt] = (f32x4){0.f, 0.f, 0.f, 0.f};
    float m_state = 0.f;
    const bf16x8 ones8 = (c16 == 0) ? (bf16x8){0x3F80, 0x3F80, 0x3F80, 0x3F80, 0x3F80, 0x3F80, 0x3F80, 0x3F80} : (bf16x8){0, 0, 0, 0, 0, 0, 0, 0};
    v4u rq[4], rk[4], rv0, rv1; float2 ra, rbp, rch;
#define ML_LOAD(CI) do { const int ci_ = (CI); const bool ic_ = ci_ < 2; const int cc_ = ic_ ? ci_ : ci_ - 2; const int len_ = ic_ ? TCX : TL; const int rb_ = ic_ ? ML + b * TCX : b * TL; \
        const int i0_ = 128 * cc_ + 2 * lane; const int t0_ = dir ? len_ - 1 - i0_ : i0_; const int t1_ = dir ? t0_ - 1 : t0_ + 1; \
        const bf16* p0_ = PM + (size_t)(rb_ + t0_) * 2048 + h * 128 + 16 * wv; const bf16* p1_ = PM + (size_t)(rb_ + t1_) * 2048 + h * 128 + 16 * wv; \
        rq[0] = *(const v4u*)p0_; rq[1] = *(const v4u*)(p0_ + 8); rq[2] = *(const v4u*)p1_; rq[3] = *(const v4u*)(p1_ + 8); \
        rk[0] = *(const v4u*)(p0_ + 512); rk[1] = *(const v4u*)(p0_ + 520); rk[2] = *(const v4u*)(p1_ + 512); rk[3] = *(const v4u*)(p1_ + 520); \
        rv0 = *(const v4u*)(PM + (size_t)(rb_ + t0_) * 2048 + 1024 + h * 128 + slice * DVS + 8 * wv); rv1 = *(const v4u*)(PM + (size_t)(rb_ + t1_) * 2048 + 1024 + h * 128 + slice * DVS + 8 * wv); \
        ra = ga[64 * ci_ + lane]; rbp = bp[128 * ci_ + tl]; rch = ch[ci_]; } while (0)
    ML_LOAD(0);
    __syncthreads();
    for (int ci = 0; ci < 34; ++ci) {
        const bool isctx = ci < 2; const int cc = isctx ? ci : ci - 2; const int len = isctx ? TCX : TL; const int rowbase = isctx ? ML + b * TCX : b * TL;
        const float a0 = ra.x, a1 = ra.y, b_last = rch.x, amax = rch.y, bt = rbp.x, pmt = rbp.y;
        const float m_new = fmaxf(b_last + m_state, b_last + amax);
        const float decay = __expf(b_last + m_state - m_new);
        const float w0 = __expf(a0 + b_last - m_new), w1 = __expf(a1 + b_last - m_new);
        const float m_t = bt + fmaxf(m_state, pmt);
        const float w_inter = __expf(bt + m_state - m_t);
        const float dbase = bt - m_t;
        ((float2*)AV)[lane] = make_float2(a0, a1);
        *(v4u*)(qs_w) = rq[0]; *(v4u*)(qs_w + 8) = rq[1]; *(v4u*)(qs_w + RS) = rq[2]; *(v4u*)(qs_w + RS + 8) = rq[3];
        *(v4u*)(ks_w) = rk[0]; *(v4u*)(ks_w + 8) = rk[1]; *(v4u*)(ks_w + RS) = rk[2]; *(v4u*)(ks_w + RS + 8) = rk[3];
#pragma unroll
        for (int half = 0; half < 2; ++half)
#pragma unroll
            for (int e = 0; e < 4; ++e) { const unsigned k0w = rk[half][e], k1w = rk[2 + half][e];
                *(unsigned*)(kt_w + (8 * half + 2 * e) * RS) = pk2(bflo(k0w) * w0, bflo(k1w) * w1);
                *(unsigned*)(kt_w + (8 * half + 2 * e + 1) * RS) = pk2(bfhi(k0w) * w0, bfhi(k1w) * w1); }
#pragma unroll
        for (int e = 0; e < 4; ++e) { *(unsigned*)(vt_w + (2 * e) * RS) = (rv0[e] & 0xffffu) | (rv1[e] << 16); *(unsigned*)(vt_w + (2 * e + 1) * RS) = (rv0[e] >> 16) | (rv1[e] & 0xffff0000u); }
        if (ci + 1 < 34) ML_LOAD(ci + 1);
        __syncthreads();
        int tlo_ = tl; asm volatile("" : "+v"(tlo_));
        bf16x8 qf[4];
#pragma unroll
        for (int kk = 0; kk < 4; ++kk) qf[kk] = *(const bf16x8*)(qs_f + 32 * kk);
        f32x4 ao[NMT + 1];
#pragma unroll
        for (int mt = 0; mt <= NMT; ++mt) { ao[mt] = (f32x4){0.f, 0.f, 0.f, 0.f};
#pragma unroll
            for (int kk = 0; kk < 4; ++kk) { const bf16x8 a = *(const bf16x8*)(cs_f + 16 * mt * RS + 32 * kk); ao[mt] = MFMA16(a, qf[kk], ao[mt]); }
            ao[mt] = ao[mt] * w_inter; }
#pragma unroll
        for (int jj = 0; jj < 4; ++jj) {
            if (2 * jj <= tt) {
                f32x4 sv[2];
#pragma unroll
                for (int u = 0; u < 2; ++u) { const int st = 2 * jj + u; sv[u] = (f32x4){0.f, 0.f, 0.f, 0.f};
                    if (st <= tt) {
#pragma unroll
                        for (int kk = 0; kk < 4; ++kk) { const bf16x8 a = *(const bf16x8*)(ks_f + 16 * st * RS + 32 * kk); sv[u] = MFMA16(a, qf[kk], sv[u]); }
                        const f32x4 av = *(const f32x4*)(av_r + 16 * st);
#pragma unroll
                        for (int j = 0; j < 4; ++j) { const int s = 16 * st + 4 * quad + j; const float p = sv[u][j] * __expf(dbase + av[j]); sv[u][j] = (s <= tlo_) ? p : 0.f; }
                    } }
                bf16x8 pb; { v4u t; t.x = pk2(sv[0][0], sv[0][1]); t.y = pk2(sv[0][2], sv[0][3]); t.z = pk2(sv[1][0], sv[1][1]); t.w = pk2(sv[1][2], sv[1][3]); pb = __builtin_bit_cast(bf16x8, t); }
#pragma unroll
                for (int mt = 0; mt < NMT; ++mt) {
                    const bf16x4 lo = *(const bf16x4*)(vt4_f + 16 * mt * RS + 32 * jj), hi = *(const bf16x4*)(vt4_f + 16 * mt * RS + 32 * jj + 16);
                    const bf16x8 a = __builtin_shufflevector(lo, hi, 0, 1, 2, 3, 4, 5, 6, 7);
                    ao[mt] = MFMA16(a, pb, ao[mt]); }
                ao[NMT] = MFMA16(ones8, pb, ao[NMT]);
            }
        }
        {
            const float den = __shfl(ao[NMT][0], c16);
            const float inv = __builtin_amdgcn_rcpf(fmaxf(fabsf(den), __expf(-m_t)));
            const int tokt = dir ? len - 1 - (128 * cc + tl) : 128 * cc + tl;
            bf16* hp = Hout + (size_t)(rowbase + tokt) * 512 + h * 128 + slice * DVS + 4 * quad;
#pragma unroll
            for (int mt = 0; mt < NMT; ++mt) { v2u o; o.x = pk2(ao[mt][0] * inv, ao[mt][1] * inv); o.y = pk2(ao[mt][2] * inv, ao[mt][3] * inv); *(v2u*)(hp + 16 * mt) = o; }
        }
#pragma unroll
        for (int mt = 0; mt <= NMT; ++mt) { Cacc[mt] = Cacc[mt] * decay;
#pragma unroll
            for (int kk = 0; kk < 4; ++kk) {
                const bf16x8 bk = *(const bf16x8*)(kt_f + 32 * kk);
                const bf16x8 a = (mt < NMT) ? *(const bf16x8*)(vt8_f + 16 * mt * RS + 32 * kk) : ones8;
                Cacc[mt] = MFMA16(a, bk, Cacc[mt]); } }
        m_state = m_new;
        __syncthreads();
#pragma unroll
        for (int mt = 0; mt <= NMT; ++mt)
#pragma unroll
            for (int j = 0; j < 4; ++j) cs_w[(16 * mt + j) * RS] = (bf16)f2bf(Cacc[mt][j]);
    }
#undef ML_LOAD
    __syncthreads();
}
__global__ void __launch_bounds__(512, 2) hybrid_fwd(Args args) {
    extern __shared__ __attribute__((aligned(16))) unsigned char lds[];
    cg::grid_group grid = cg::this_grid();
    const int tid = threadIdx.x, lane = tid & 63, wave = __builtin_amdgcn_readfirstlane(tid >> 6);
    const int G = gridDim.x; const int bx = blockIdx.x;
    const int vcu = (G % 8 == 0) ? (bx % 8) * (G / 8) + bx / 8 : bx;
    const int gw = vcu * 8 + wave, NGW = G * 8;
    if (tid == 0) {
        LAS unsigned long long* tab = (LAS unsigned long long*)((LAS unsigned char*)lds + TAB_OFF);
        tab[0] = (unsigned long long)args.in[0]; tab[1] = (unsigned long long)args.in[1]; tab[2] = (unsigned long long)args.in[2]; tab[3] = (unsigned long long)args.in[3];
        tab[4] = (unsigned long long)args.in[4]; tab[5] = (unsigned long long)args.in[5]; tab[6] = (unsigned long long)args.in[6]; tab[7] = (unsigned long long)args.in[7];
        tab[8] = (unsigned long long)args.in[8]; tab[9] = (unsigned long long)args.in[9]; tab[10] = (unsigned long long)args.in[10]; tab[11] = (unsigned long long)args.in[11];
        tab[12] = (unsigned long long)args.in[12]; tab[13] = (unsigned long long)args.in[13]; tab[14] = (unsigned long long)args.in[14]; tab[15] = (unsigned long long)args.in[15];
        tab[16] = (unsigned long long)args.in[16]; tab[17] = (unsigned long long)args.in[17]; tab[18] = (unsigned long long)args.out; tab[19] = (unsigned long long)args.ws;
    }
    if (tid == 0) { ((volatile LAS unsigned*)((LAS unsigned char*)lds + TAB_OFF + 224))[0] = 0u; ((volatile LAS unsigned*)((LAS unsigned char*)lds + TAB_OFF + 224))[1] = 0u; }
    __syncthreads();
    XcdBarrier bar = xcd_barrier_post((unsigned*)args.ws, (volatile LAS unsigned*)((LAS unsigned char*)lds + TAB_OFF + 224));
#define GSYNC() do { XcdBarrier b_; b_.bar = (unsigned*)rd_ptr(lds, 19); b_.x = xb_xcc_id(); b_.st = (volatile LAS unsigned*)((LAS unsigned char*)lds + TAB_OFF + 224); xcd_barrier(b_); } while (0)
#define INP(k) ((const float*)rd_ptr(lds, (k)))
#define WSP(off) ((unsigned char*)rd_ptr(lds, 19) + (off))
#define x_in INP(0)
#define c_in INP(1)
#define ctx_in INP(2)
#define cctx_in INP(3)
#define w_ada INP(4)
#define b_ada INP(5)
#define norm_mix INP(6)
#define norm_mlp INP(7)
#define w_in INP(8)
#define b_gates INP(9)
#define conv_qk INP(10)
#define q_norm INP(11)
#define k_norm INP(12)
#define mlstm_norm INP(13)
#define w_out INP(14)
#define w_mlp_in INP(15)
#define w_mlp_out INP(16)
#define norm_final INP(17)
#define MOD ((float*)WSP(WS_MOD))
#define WIN ((bf16*)WSP(WS_WIN))
#define WOUT ((bf16*)WSP(WS_WOUT))
#define W1 ((bf16*)WSP(WS_W1))
#define W2 ((bf16*)WSP(WS_W2))
#define X ((bf16*)WSP(WS_X))
#define XN ((bf16*)WSP(WS_XN))
#define HF ((bf16*)WSP(WS_XN))
#define HB ((bf16*)WSP(WS_HB))
#define AO ((bf16*)WSP(WS_AO))
#define PM ((bf16*)WSP(WS_PM))
#define KB ((bf16*)WSP(WS_K))
#define VB ((bf16*)WSP(WS_V))
#define GT ((float*)WSP(WS_G))
#define HH ((bf16*)WSP(WS_H))

        if (PHMASK & (1 << 0))
        for (int rep_ = 0; rep_ < REP_0; ++rep_)
    {
        float* sil = (float*)lds;
        float* red = (float*)(lds + 9 * 1024 * 4);
        for (int i = tid; i < 9 * 1024; i += 512) { const float v = (i < 8192) ? c_in[i] : cctx_in[i - 8192]; sil[i] = siluf_(v); }
        __syncthreads();
        for (int it = bx; it < DEPTH * 48; it += G) {
            const int l = it / 48, nb = it % 48; const int kq = tid >> 7, nn = tid & 127, n = nb * 128 + nn;
            const float* wp = w_ada + (size_t)l * 1024 * 6144 + (size_t)(kq * 256) * 6144 + n;
            float acc[9];
#pragma unroll
            for (int r = 0; r < 9; ++r) acc[r] = 0.f;
#pragma unroll 8
            for (int k = 0; k < 256; ++k) { const float wv = wp[(size_t)k * 6144];
#pragma unroll
                for (int r = 0; r < 9; ++r) acc[r] += sil[r * 1024 + kq * 256 + k] * wv; }
#pragma unroll
            for (int r = 0; r < 9; ++r) red[(kq * 9 + r) * 128 + nn] = acc[r];
            __syncthreads();
            for (int i = tid; i < 9 * 128; i += 512) { const int r = i >> 7, c = i & 127;
                const float s = red[(0 * 9 + r) * 128 + c] + red[(1 * 9 + r) * 128 + c] + red[(2 * 9 + r) * 128 + c] + red[(3 * 9 + r) * 128 + c];
                MOD[((size_t)l * 9 + r) * 6144 + nb * 128 + c] = s + b_ada[(size_t)l * 6144 + nb * 128 + c]; }
            __syncthreads();
        }
        {
            float* scr = (float*)(lds + wave * 8448);
            constexpr int I_IN = 16 * 96, I_OUT = 16 * 32, I_1 = 16 * 128, I_2 = 64 * 32;
            for (int it = gw; it < I_IN + I_OUT + I_1 + I_2; it += NGW) {
                int r = it;
                if (r < I_IN) { transpose_item(w_in, 1024, NIN, 96, WIN, scr, r, lane); continue; } r -= I_IN;
                if (r < I_OUT) { transpose_item(w_out, 1024, 1024, 32, WOUT, scr, r, lane); continue; } r -= I_OUT;
                if (r < I_1) { transpose_item(w_mlp_in, 1024, FF, 128, W1, scr, r, lane); continue; } r -= I_1;
                transpose_item(w_mlp_out, FF, 1024, 32, W2, scr, r, lane);
            }
        }
    }
    if (args.out == nullptr) grid.sync();
    GSYNC();

    for (int layer = 0; layer < DEPTH; ++layer) {
        const int tid = opaque_tid(), lane = tid & 63;
        const bool emit_ctx = layer < DEPTH - 1;
        const int Mout = emit_ctx ? MT : ML;
#define modl (MOD + (size_t)layer * 9 * 6144)
#define xlat (layer == 0 ? (const void*)x_in : (const void*)X)
#define xctx (layer == 0 ? (const void*)ctx_in : (const void*)(X + (size_t)ML * 1024))

        if (PHMASK & (1 << 1))
        for (int rep_ = 0; rep_ < REP_A; ++rep_)
        {
            float* scr = (float*)(lds + wave * 8448);
            constexpr int I_IN = 16 * 96, I_OUT = 16 * 32, I_1 = 16 * 128, I_2 = 64 * 32;
            if (layer > 0)
            for (int it = gw; it < I_IN + I_OUT + I_1 + I_2; it += NGW) {
                int r = it;
                if (r < I_IN) { transpose_item(w_in + (size_t)layer * 1024 * NIN, 1024, NIN, 96, WIN, scr, r, lane); continue; } r -= I_IN;
                if (r < I_OUT) { transpose_item(w_out + (size_t)layer * 1024 * 1024, 1024, 1024, 32, WOUT, scr, r, lane); continue; } r -= I_OUT;
                if (r < I_1) { transpose_item(w_mlp_in + (size_t)layer * 1024 * FF, 1024, FF, 128, W1, scr, r, lane); continue; } r -= I_1;
                transpose_item(w_mlp_out + (size_t)layer * FF * 1024, FF, 1024, 32, W2, scr, r, lane);
            }
            if (layer == 0) {
                for (int row = gw; row < ML; row += 4 * NGW)
                    modulate_rows4<false>(x_in, XN, row, NGW, modl, 0, 1024, norm_mix + layer * 1024, lane);
                for (int row = ML + gw; row < MT; row += NGW)
                    modulate_row<false>(ctx_in + (size_t)(row - ML) * 1024, XN + (size_t)row * 1024, norm_mix + layer * 1024, modl + 8 * 6144 + 0, modl + 8 * 6144 + 1024, lane);
            } else {
                for (int row = gw; row < ML; row += 4 * NGW)
                    modulate_rows4<true>(X, XN, row, NGW, modl, 0, 1024, norm_mix + layer * 1024, lane);
                if (rep_ + 1 >= REP_A)
                for (int row = ML + gw; row < MT; row += NGW)
                    modulate_row_part<true>(X + (size_t)row * 1024, X + (size_t)row * 1024, (const bf16*)rd_ptr(lds, 18) + (size_t)(row - ML) * 1024, MOD + ((size_t)(layer - 1) * 9 + 8) * 6144 + 5120,
                                            XN + (size_t)row * 1024, norm_mix + layer * 1024, modl + 8 * 6144 + 0, modl + 8 * 6144 + 1024, lane);
            }
        }
        GSYNC();

        if (PHMASK & (1 << 2))
        for (int rep_ = 0; rep_ < REP_B; ++rep_)
        {
            pg8::Gemm g{XN, WIN, MT, NINP, 1024, 0}; pg8::ThinLastOrder S; S.init(MT, G, bx);
            pg8::EpiIn E{AO, PM, (bf16*)rd_ptr(lds, 18), GT, b_gates + layer * 16};
            pg8::gemm_phase<pg8::EpiIn, pg8::ThinLastOrder, true, true, 11>((PG8_LAS unsigned char*)lds, g, S, E);
        }
        GSYNC();

        {
            const bf16* RAW = (const bf16*)rd_ptr(lds, 18);
            float cw[2][3][8];
#pragma unroll
            for (int p = 0; p < 2; ++p)
#pragma unroll
                for (int tap = 0; tap < 3; ++tap) { const float* cp = conv_qk + (size_t)layer * 3072 + tap * 1024 + 512 * p + 8 * lane;
                    const f32x4 c0 = *(const f32x4*)cp, c1 = *(const f32x4*)(cp + 4);
#pragma unroll
                    for (int e = 0; e < 4; ++e) { cw[p][tap][e] = c0[e]; cw[p][tap][4 + e] = c1[e]; } }
#define PC_CONV_ROWS(NR, ROWBASE, STRIDE) do { \
                v4u r0[NR][2], r1[NR][2], r2[NR][2]; \
                _Pragma("unroll") for (int q = 0; q < NR; ++q) { const int row = (ROWBASE) + q * (STRIDE); \
                    const bool islat = row < ML; const int t = islat ? row & 4095 : (row - ML) & 255; const int len = islat ? TL : TCX; \
                    const bool vm = t > 0, vp = t < len - 1; \
                    const bf16* rp = RAW + (size_t)row * 1024 + 8 * lane; \
                    const v4u z4 = (v4u){0u, 0u, 0u, 0u}; \
                    _Pragma("unroll") for (int p = 0; p < 2; ++p) { r1[q][p] = *(const v4u*)(rp + 512 * p); r0[q][p] = vm ? *(const v4u*)(rp + 512 * p - 1024) : z4; r2[q][p] = vp ? *(const v4u*)(rp + 512 * p + 1024) : z4; } } \
                _Pragma("unroll") for (int q = 0; q < NR; ++q) \
                    _Pragma("unroll") for (int p = 0; p < 2; ++p) { \
                        const float scl = p ? 0.08838834764831845f : 1.f; \
                        v4u o; \
                        _Pragma("unroll") for (int e = 0; e < 4; ++e) { \
                            const float x0 = cw[p][0][2 * e] * bflo(r0[q][p][e]) + cw[p][1][2 * e] * bflo(r1[q][p][e]) + cw[p][2][2 * e] * bflo(r2[q][p][e]); \
                            const float x1 = cw[p][0][2 * e + 1] * bfhi(r0[q][p][e]) + cw[p][1][2 * e + 1] * bfhi(r1[q][p][e]) + cw[p][2][2 * e + 1] * bfhi(r2[q][p][e]); \
                            const float y0 = x0 * __builtin_amdgcn_rcpf(1.f + __builtin_amdgcn_exp2f(-1.4426950408889634f * x0)) * scl; \
                            const float y1 = x1 * __builtin_amdgcn_rcpf(1.f + __builtin_amdgcn_exp2f(-1.4426950408889634f * x1)) * scl; \
                            o[e] = pk2(y0, y1); } \
                        *(v4u*)(PM + (size_t)((ROWBASE) + q * (STRIDE)) * 2048 + 512 * p + 8 * lane) = o; } } while (0)
            for (int row0 = gw; row0 < ML; row0 += 4 * NGW) PC_CONV_ROWS(4, row0, NGW);
            for (int row0 = ML + gw; row0 < MT; row0 += NGW) PC_CONV_ROWS(1, row0, 0);
#undef PC_CONV_ROWS
            float* GAp = (float*)WSP(WS_GA); float* BPp = (float*)WSP(WS_BP); float* CHp = (float*)WSP(WS_CH); const float* gates = GT;
            for (int it = gw; it < 64 * 34; it += NGW) {
                const int chain = it / 34, ci = it - chain * 34; const int b = chain >> 3, h = (chain >> 1) & 3, dir = chain & 1;
                const bool isctx = ci < 2; const int cc = isctx ? ci : ci - 2; const int len = isctx ? TCX : TL; const int rowbase = isctx ? ML + b * TCX : b * TL;
                const int gi = (dir ? 8 : 0) + h, gf = (dir ? 12 : 4) + h;
                const int i0 = 128 * cc + 2 * lane;
                const int tok0 = dir ? len - 1 - i0 : i0, tok1 = dir ? tok0 - 1 : tok0 + 1;
                const float* g0 = gates + (size_t)(rowbase + tok0) * 16; const float* g1 = gates + (size_t)(rowbase + tok1) * 16;
                const float ig0 = g0[gi], ig1 = g1[gi], lf0 = logsigmoidf_(g0[gf]), lf1 = logsigmoidf_(g1[gf]);
                float sc = lf0 + lf1;
#pragma unroll
                for (int o = 1; o < 64; o <<= 1) { const float tt = __shfl_up(sc, o); if (lane >= o) sc += tt; }
                const float b1 = sc, b0 = sc - lf1;
                const float a0 = ig0 - b0, a1 = ig1 - b1;
                float sm = fmaxf(a0, a1);
#pragma unroll
                for (int o = 1; o < 64; o <<= 1) { const float tt = __shfl_up(sm, o); if (lane >= o) sm = fmaxf(sm, tt); }
                float pme = __shfl_up(sm, 1); if (lane == 0) pme = -INFINITY;
                const float pm0 = fmaxf(pme, a0), pm1 = sm;
                const size_t base = (size_t)chain * KVLEN + 128 * ci + 2 * lane;
                *(float2*)(GAp + base) = make_float2(a0, a1);
                *(f32x4*)(BPp + 2 * base) = (f32x4){b0, pm0, b1, pm1};
                if (lane == 63) *(float2*)(CHp + 2 * (chain * 34 + ci)) = make_float2(b1, sm);
            }
        }
        {
            float2* rt = (float2*)lds;
            for (int i = tid; i < 1024; i += 512) { const int pp = i >> 4, fi = i & 15;
                const float invf = exp2f(-(float)(2 * fi) * (13.287712379549449f / 32.f)); float sv, cv; sincosf((float)pp * invf, &sv, &cv); rt[i] = make_float2(cv, sv); }
            __syncthreads();
            const int l8 = lane & 7, lk = lane & 15;
            float qg[8], kg[8];
#pragma unroll
            for (int e = 0; e < 8; ++e) { qg[e] = q_norm[layer * 64 + 8 * l8 + e] * attn_body::C2; kg[e] = k_norm[layer * 64 + 8 * l8 + e]; }
#define PC_QK_ROWS(NR, ROWBASE, STRIDE) do { \
                v4u rawq[NR], rawk[NR], rawv[NR]; \
                _Pragma("unroll") for (int q = 0; q < NR; ++q) { const bf16* ar = AO + (size_t)((ROWBASE) + q * (STRIDE)) * 1024; \
                    rawq[q] = *(const v4u*)(ar + 8 * lane); rawk[q] = *(const v4u*)(ar + 512 + 8 * lk); rawv[q] = *(const v4u*)(ar + 640 + 8 * lk); } \
                _Pragma("unroll") for (int q = 0; q < NR; ++q) { \
                    const int row = (ROWBASE) + q * (STRIDE); \
                    const bool islat = row < ML; const int b = islat ? row >> 12 : (row - ML) >> 8; const int t = islat ? row & 4095 : (row - ML) & 255; \
                    const int pos = islat ? TCX + t : t; \
                    bf16* ar = AO + (size_t)row * 1024; \
                    float cs[4], sn[4]; \
                    { const int pp = (l8 < 4) ? (t >> 6) : (t & 63); const f32x4* tp = (const f32x4*)(rt + pp * 16 + 4 * (l8 & 3)); \
                      const f32x4 t0 = tp[0], t1 = tp[1]; \
                      if (islat) { cs[0] = t0[0]; sn[0] = t0[1]; cs[1] = t0[2]; sn[1] = t0[3]; cs[2] = t1[0]; sn[2] = t1[1]; cs[3] = t1[2]; sn[3] = t1[3]; } \
                      else { cs[0] = cs[1] = cs[2] = cs[3] = 1.f; sn[0] = sn[1] = sn[2] = sn[3] = 0.f; } } \
                    { float v[8]; \
                        _Pragma("unroll") for (int e = 0; e < 4; ++e) { v[2 * e] = bflo(rawq[q][e]); v[2 * e + 1] = bfhi(rawq[q][e]); } \
                        float ss = 0.f; \
                        _Pragma("unroll") for (int e = 0; e < 8; ++e) ss += v[e] * v[e]; \
                        ss += __shfl_xor(ss, 1); ss += __shfl_xor(ss, 2); ss += __shfl_xor(ss, 4); \
                        const float r = rsqrtf(ss * (1.f / 64.f) + EPS); \
                        v4u o; \
                        _Pragma("unroll") for (int j = 0; j < 4; ++j) { const float x0 = v[2 * j] * r * qg[2 * j], x1 = v[2 * j + 1] * r * qg[2 * j + 1]; \
                            o[j] = pk2(x0 * cs[j] - x1 * sn[j], x0 * sn[j] + x1 * cs[j]); } \
                        *(v4u*)(ar + 8 * lane) = o; } \
                    { float v[8]; \
                        _Pragma("unroll") for (int e = 0; e < 4; ++e) { v[2 * e] = bflo(rawk[q][e]); v[2 * e + 1] = bfhi(rawk[q][e]); } \
                        float ss = 0.f; \
                        _Pragma("unroll") for (int e = 0; e < 8; ++e) ss += v[e] * v[e]; \
                        ss += __shfl_xor(ss, 1); ss += __shfl_xor(ss, 2); ss += __shfl_xor(ss, 4); \
                        const float r = rsqrtf(ss * (1.f / 64.f) + EPS); \
                        v4u o; \
                        _Pragma("unroll") for (int j = 0; j < 4; ++j) { const float x0 = v[2 * j] * r * kg[2 * j], x1 = v[2 * j + 1] * r * kg[2 * j + 1]; \
                            o[j] = pk2(x0 * cs[j] - x1 * sn[j], x0 * sn[j] + x1 * cs[j]); } \
                        const size_t kvrow = ((size_t)b * KVLEN + pos) * 128; \
                        if (lane < 16) *(v4u*)(KB + kvrow + 8 * lk) = o; \
                        else if (lane < 32) *(v4u*)(VB + kvrow + 8 * lk) = rawv[q]; } } } while (0)
            for (int row0 = gw; row0 < ML; row0 += 4 * NGW) PC_QK_ROWS(4, row0, NGW);
            for (int row0 = ML + gw; row0 < MT; row0 += NGW) PC_QK_ROWS(1, row0, 0);
#undef PC_QK_ROWS
        }
        GSYNC();

        {
            unsigned* ctr = (unsigned*)WSP(14336) + 64 * layer;
            unsigned* mdone = (unsigned*)WSP(15360) + 64 * layer;
            bool had_item = false;
            for (int item = (vcu & 1) ? 128 : (vcu >> 1); item < 128; item += (G >> 1)) {
                mlstm_item(item, PM, (const float*)WSP(WS_GA), (const float*)WSP(WS_BP), (const float*)WSP(WS_CH), HF, HB, (char*)lds); had_item = true; }
            if (had_item) {
                asm volatile("s_waitcnt vmcnt(0)" ::: "memory"); __syncthreads();
                if (tid == 0) { __builtin_amdgcn_fence(__ATOMIC_RELEASE, "agent"); asm volatile("s_waitcnt vmcnt(0)" ::: "memory");
                    int n_it = 0; for (int item = (vcu & 1) ? 128 : (vcu >> 1); item < 128; item += (G >> 1)) ++n_it;
                    __hip_atomic_fetch_add(mdone, (unsigned)n_it, __ATOMIC_RELAXED, __HIP_MEMORY_SCOPE_AGENT); }
            }
            __syncthreads();
            volatile LAS unsigned* uw = (volatile LAS unsigned*)((LAS unsigned char*)lds + TAB_OFF + 232);
            const int NPE = Mout / 128;
            const int total = 1024 + NPE + (emit_ctx ? 64 : 0);
            bool acquired = false;
            for (;;) {
                if (tid == 0) uw[0] = __hip_atomic_fetch_add(ctr, 1u, __ATOMIC_RELAXED, __HIP_MEMORY_SCOPE_AGENT);
                __syncthreads();
                const int u = __builtin_amdgcn_readfirstlane((int)uw[0]);
                if (u >= total) break;
                if (u < 1024) {
                    const int bkv = u >> 6, rem = u & 63, hq = rem >> 4, qb = rem & 15; const int b = bkv >> 1, kvh = bkv & 1, h = kvh * 4 + hq;
                    attn_body::attn_unit<8>((attn_body::bf16*)(AO + ((size_t)b * TL + qb * 256) * 1024 + h * 64), (attn_body::bf16*)(AO + ((size_t)b * TL + qb * 256) * 1024 + h * 64),
                                            (const attn_body::bf16*)(KB + (size_t)b * KVLEN * 128 + kvh * 64), (const attn_body::bf16*)(VB + (size_t)b * KVLEN * 128 + kvh * 64), KVLEN / 64, (char*)lds);
                } else if (u < 1024 + NPE) {
                    if (!acquired) {
                        if (tid == 0) { unsigned sp = 0; while (__hip_atomic_load(mdone, __ATOMIC_RELAXED, __HIP_MEMORY_SCOPE_AGENT) < 128u && ++sp < (1u << 22)) __builtin_amdgcn_s_sleep(8);
                            __builtin_amdgcn_fence(__ATOMIC_ACQUIRE, "agent"); asm volatile("s_waitcnt vmcnt(0)" ::: "memory"); }
                        __syncthreads(); acquired = true;
                    }
                    const int r0 = (u - 1024) * 128 + wave * 16;
                    float gnv[8];
#pragma unroll
                    for (int e = 0; e < 8; ++e) gnv[e] = mlstm_norm[layer * 512 + 8 * lane + e];
                    for (int rr = 0; rr < 16; rr += 4) {
                        const int row = r0 + rr;
                        v4u a[4], bq[4], og[4];
#pragma unroll
                        for (int q = 0; q < 4; ++q) { a[q] = *(const v4u*)(HF + (size_t)(row + q) * 512 + 8 * lane); bq[q] = *(const v4u*)(HB + (size_t)(row + q) * 512 + 8 * lane); og[q] = *(const v4u*)(PM + (size_t)(row + q) * 2048 + 1536 + 8 * lane); }
#pragma unroll
                        for (int q = 0; q < 4; ++q) {
                            float v[8]; float ss = 0.f;
#pragma unroll
                            for (int e = 0; e < 4; ++e) { v[2 * e] = bflo(a[q][e]) + bflo(bq[q][e]); v[2 * e + 1] = bfhi(a[q][e]) + bfhi(bq[q][e]); }
#pragma unroll
                            for (int e = 0; e < 8; ++e) ss += v[e] * v[e];
                            ss += __shfl_xor(ss, 1); ss += __shfl_xor(ss, 2); ss += __shfl_xor(ss, 4); ss += __shfl_xor(ss, 8);
                            const float r = rsqrtf(ss * (1.f / 128.f) + EPS);
                            v4u o;
#pragma unroll
                            for (int e = 0; e < 4; ++e) { const float s0 = __builtin_amdgcn_rcpf(1.f + __builtin_amdgcn_exp2f(-1.4426950408889634f * bflo(og[q][e]))), s1 = __builtin_amdgcn_rcpf(1.f + __builtin_amdgcn_exp2f(-1.4426950408889634f * bfhi(og[q][e])));
                                o[e] = pk2(s0 * v[2 * e] * r * gnv[2 * e], s1 * v[2 * e + 1] * r * gnv[2 * e + 1]); }
                            *(v4u*)(AO + (size_t)(row + q) * 1024 + 512 + 8 * lane) = o;
                        }
                    }
                    __syncthreads();
                } else {
                    const int c = u - 1024 - NPE, b = c >> 3, h = c & 7, kvh = h >> 2;
                    attn_body::attn_unit<8>((attn_body::bf16*)(AO + ((size_t)ML + b * TCX) * 1024 + h * 64), (attn_body::bf16*)(AO + ((size_t)ML + b * TCX) * 1024 + h * 64),
                                            (const attn_body::bf16*)(KB + (size_t)b * KVLEN * 128 + kvh * 64), (const attn_body::bf16*)(VB + (size_t)b * KVLEN * 128 + kvh * 64), TCX / 64, (char*)lds);
                }
            }
        }
        GSYNC();

        if (PHMASK & (1 << 6))
        for (int rep_ = 0; rep_ < REP_F; ++rep_)
        {
            pg8::Gemm g{AO, WOUT, Mout, 1024, 1024, 0}; pg8::SplitOrder S; S.init(G, bx, 1024, emit_ctx);
            pg8::EpiRes E{xlat, xctx, (rep_ + 1 < REP_F) ? XN : X, modl + 2048, (rep_ + 1 < REP_F) ? 32767u : 0xffffffffu, (bf16*)rd_ptr(lds, 18), layer > 0};
            pg8::gemm_phase<pg8::EpiRes, pg8::SplitOrder, true, true>((PG8_LAS unsigned char*)lds, g, S, E);
        }
        GSYNC();

        if (PHMASK & (1 << 7))
        for (int rep_ = 0; rep_ < REP_G; ++rep_)
        {
            for (int row = gw; row < ML; row += 4 * NGW)
                modulate_rows4<true>(X, XN, row, NGW, modl, 3072, 4096, norm_mlp + layer * 1024, lane);
            if (emit_ctx && rep_ + 1 >= REP_G)
                for (int row = ML + gw; row < MT; row += NGW) {
                    if (layer == 0) modulate_row_part<false>(ctx_in + (size_t)(row - ML) * 1024, X + (size_t)row * 1024, (const bf16*)rd_ptr(lds, 18) + (size_t)(row - ML) * 1024, modl + 8 * 6144 + 2048,
                                                             XN + (size_t)row * 1024, norm_mlp + layer * 1024, modl + 8 * 6144 + 3072, modl + 8 * 6144 + 4096, lane);
                    else modulate_row_part<true>(X + (size_t)row * 1024, X + (size_t)row * 1024, (const bf16*)rd_ptr(lds, 18) + (size_t)(row - ML) * 1024, modl + 8 * 6144 + 2048,
                                                 XN + (size_t)row * 1024, norm_mlp + layer * 1024, modl + 8 * 6144 + 3072, modl + 8 * 6144 + 4096, lane);
                }
        }
        GSYNC();

        if (PHMASK & (1 << 8))
        for (int rep_ = 0; rep_ < REP_H; ++rep_)
        {
            pg8::Gemm g{XN, W1, Mout, FF, 1024, 0}; pg8::StaticOrder S; S.init(Mout, FF, G, bx); S.ntf = 16;
            pg8::EpiUp E{HH};
            pg8::gemm_phase<pg8::EpiUp, pg8::StaticOrder, true, true>((PG8_LAS unsigned char*)lds, g, S, E);
        }
        GSYNC();

        if (PHMASK & (1 << 9))
        for (int rep_ = 0; rep_ < REP_I; ++rep_)
        {
            pg8::Gemm g{HH, W2, Mout, 1024, FF, 1}; pg8::SplitOrder S; S.init(G, bx, FF, emit_ctx);
            pg8::EpiRes E{X, X + (size_t)ML * 1024, (rep_ + 1 < REP_I) ? XN : X, modl + 5120, (rep_ + 1 < REP_I) ? 32767u : 0xffffffffu, (bf16*)rd_ptr(lds, 18), 1};
            pg8::gemm_phase<pg8::EpiRes, pg8::SplitOrder, true, true>((PG8_LAS unsigned char*)lds, g, S, E);
        }
        GSYNC();
    }

        if (PHMASK & (1 << 10))
        for (int rep_ = 0; rep_ < REP_Z; ++rep_)
    for (int row = gw; row < ML; row += 4 * NGW) {
        f32x4 v[4][4]; float ss[4];
#pragma unroll
        for (int q = 0; q < 4; ++q)
#pragma unroll
            for (int j = 0; j < 4; ++j) v[q][j] = ldx4<true>(X + (size_t)(row + q * NGW) * 1024, lane + 64 * j);
#pragma unroll
        for (int q = 0; q < 4; ++q) { float a = 0.f;
#pragma unroll
            for (int j = 0; j < 4; ++j) a += (v[q][j].x * v[q][j].x + v[q][j].y * v[q][j].y) + (v[q][j].z * v[q][j].z + v[q][j].w * v[q][j].w);
            ss[q] = a; }
#pragma unroll
        for (int o = 1; o < 64; o <<= 1) {
#pragma unroll
            for (int q = 0; q < 4; ++q) ss[q] += __shfl_xor(ss[q], o); }
#pragma unroll
        for (int q = 0; q < 4; ++q) { const float r = rsqrtf(ss[q] * (1.f / DM) + EPS);
            f32x4* o = (f32x4*)((float*)rd_ptr(lds, 18) + (size_t)(row + q * NGW) * 1024) + lane;
#pragma unroll
            for (int j = 0; j < 4; ++j) o[64 * j] = v[q][j] * r * *(const f32x4*)(norm_final + 4 * lane + 256 * j); }
    }
}

extern "C" void kernel_launch(void* const* d_in, const int* in_sizes, int n_in, void* d_out, int out_size, void* d_ws, size_t ws_size, hipStream_t stream) {
    static int grid = 0;
    if (grid == 0) {
        if (n_in != 18 || in_sizes[0] != ML * DM || out_size != ML * DM || ws_size < WS_END) {
            fprintf(stderr, "kernel_launch: unexpected shapes: n_in %d in0 %d out %d ws %zu (need %zu)\n", n_in, n_in > 0 ? in_sizes[0] : -1, out_size, ws_size, (size_t)WS_END); grid = -1; return; }
        int dev = 0, cus = 0, per_cu = 0;
        (void)hipGetDevice(&dev); (void)hipDeviceGetAttribute(&cus, hipDeviceAttributeMultiprocessorCount, dev);
        if (hipFuncSetAttribute((const void*)hybrid_fwd, hipFuncAttributeMaxDynamicSharedMemorySize, LDS_BYTES) != hipSuccess) { fprintf(stderr, "kernel_launch: hipFuncSetAttribute failed\n"); grid = -1; return; }
        if (hipOccupancyMaxActiveBlocksPerMultiprocessor(&per_cu, (const void*)hybrid_fwd, 512, LDS_BYTES) != hipSuccess || per_cu < 1) { fprintf(stderr, "kernel_launch: occupancy query says %d\n", per_cu); per_cu = 1; }
        (void)hipGetLastError();
        if (cus != 256) { fprintf(stderr, "kernel_launch: built for 256 CUs (MI355X), found %d; nothing launched\n", cus); grid = -1; return; }
        grid = cus * 1;
    }
    if (grid < 0) return;
    if (hipMemsetAsync(d_ws, 0, 16384, stream) != hipSuccess) { fprintf(stderr, "kernel_launch: memset failed\n"); return; }
    Args a{};
    for (int i = 0; i < 18; ++i) a.in[i] = (const float*)d_in[i];
    a.out = (float*)d_out; a.ws = (unsigned char*)d_ws;
    void* kargs[] = {&a};
    hipError_t e = hipLaunchCooperativeKernel((const void*)hybrid_fwd, dim3(grid), dim3(512), kargs, LDS_BYTES, stream);
    if (e != hipSuccess) fprintf(stderr, "kernel_launch: cooperative launch failed: %s (grid %d)\n", hipGetErrorString(e), grid);
}
```

```cpp
#include <hip/hip_runtime.h>
#include <hip/hip_cooperative_groups.h>
#include <cstdio>
#include <cstdint>
namespace cg = cooperative_groups;
#ifndef REP_A
#define REP_A 1
#endif
#ifndef REP_B
#define REP_B 1
#endif
#ifndef REP_E
#define REP_E 1
#endif
#ifndef REP_G
#define REP_G 1
#endif
#ifndef REP_H
#define REP_H 1
#endif
#ifndef ATT_REPS
#define ATT_REPS 1
#endif
#ifndef REP_F
#define REP_F 1
#endif
#ifndef REP_I
#define REP_I 1
#endif
#ifndef REP_0
#define REP_0 1
#endif
#ifndef REP_C
#define REP_C 1
#endif
#ifndef REP_Z
#define REP_Z 1
#endif
#ifndef MLSTM_REPS
#define MLSTM_REPS 1
#endif
#ifndef PHMASK
#define PHMASK 0x7ff
#endif
__device__ __forceinline__ int opaque_tid() { int t = threadIdx.x; asm volatile("" : "+v"(t)); return t; }
namespace pg8 {
#define PG8_LAS __attribute__((address_space(3)))
typedef unsigned short bf16_t;
typedef short bf16x8 __attribute__((ext_vector_type(8)));
typedef float f32x4 __attribute__((ext_vector_type(4)));
typedef unsigned u32x4 __attribute__((ext_vector_type(4)));
constexpr int BM = 256, BK = 64, HALF = 128, HTB = HALF * BK * 2  , STAGE_BYTES = 8 * HTB, NXCD = 8, WGM = 8;

__host__ __device__ __forceinline__ int lds_byte(int r, int c) { const int st = (r >> 4) * 2 + (c >> 5), rr = r & 15, cc = c & 31, ob = rr * 64 + cc * 2; return st * 1024 + (ob ^ (((ob >> 9) & 1) << 5)); }
__host__ __device__ __forceinline__ void stage_rc(int b, int& R, int& C) { const int st = b / 1024, sb = b % 1024, swz = sb ^ (((sb >> 9) & 1) << 5); R = (st >> 1) * 16 + swz / 64; C = (st & 1) * 32 + (swz % 64) / 2; }
__host__ __device__ __forceinline__ int perm32(int rho) { const int n = rho >> 4, i = rho & 15; return 8 * (i >> 2) + 4 * n + (i & 3); }

struct Unit { int pm, pn, k0, nt, sl; };
struct Gemm { const bf16_t* A; const bf16_t* Bt; int M, N, K, ablk; };

struct StaticOrder {
    int nM, nN, nwg, G, c, ntf;
    __host__ __device__ void init(int M, int N, int G_, int c_) { nM = M / BM; nN = N / BM; nwg = nM * nN; G = G_; c = c_; }
    __host__ __device__ bool next(int i, Unit& u) const {
        const long L = (long)i * G + c; if (L >= nwg) return false;
        int wgid = (int)L; { const int q = nwg / NXCD, r = nwg % NXCD, xcd = wgid % NXCD, off = wgid / NXCD; wgid = (xcd < r ? xcd * (q + 1) : r * (q + 1) + (xcd - r) * q) + off; }
        const int nig = WGM * nN, gid = wgid / nig, fm = gid * WGM, gsz = (nM - fm) < WGM ? (nM - fm) : WGM;
        u = Unit{fm + ((wgid % nig) % gsz), (wgid % nig) / gsz, 0, ntf, -1}; return true;
    }
    __device__ __forceinline__ void a_ready(const Unit&) const {}
    __device__ __forceinline__ void done(const Unit&) const {}
};
struct ThinLastOrder {
    StaticOrder L; int nthin;
    __host__ __device__ void init(int M, int G_, int c_) { L.init(M, 11 * 256, G_, c_); L.ntf = 16; nthin = M / BM; }
    __host__ __device__ bool next(int i, Unit& u) const {
        const long idx = (long)i * L.G + L.c;
        if (idx < L.nwg) return L.next(i, u);
        const long t = idx - L.nwg; if (t >= nthin) return false;
        u = Unit{(int)t, 11, 0, L.ntf, -1}; return true;
    }
    __device__ __forceinline__ void a_ready(const Unit&) const {}
    __device__ __forceinline__ void done(const Unit&) const {}
};
struct SplitOrder {
    StaticOrder L; int rl, nsplit;
    __host__ __device__ void init(int G_, int c_, int K, bool with_ctx) { L.init(32768, 1024, G_, c_); L.ntf = K / 64; rl = (c_ < L.nwg) ? (L.nwg - c_ + G_ - 1) / G_ : 0; nsplit = with_ctx ? 256 : 0; }
    __host__ __device__ bool next(int i, Unit& u) const {
        if (i < rl) return L.next(i, u);
        const int j = i - rl; const long sidx = (long)j * L.G + L.c; if (sidx >= nsplit) return false;
        const int tile = (int)sidx >> 3, slice = (int)sidx & 7, nts = L.ntf / 8; u = Unit{128 + (tile >> 2), tile & 3, slice * nts * 64, nts, slice}; return true;
    }
    __device__ __forceinline__ void a_ready(const Unit&) const {}
    __device__ __forceinline__ void done(const Unit&) const {}
};

__device__ __forceinline__ unsigned cvt_pk_bf16(float lo, float hi) { unsigned r; asm volatile("v_cvt_pk_bf16_f32 %0, %1, %2" : "=v"(r) : "v"(lo), "v"(hi)); return r; }
typedef float f32x2 __attribute__((ext_vector_type(2)));
__device__ __forceinline__ f32x2 gelu_pk(f32x2 v) {
    const f32x2 av = __builtin_elementwise_abs(v), d = av * 0.2316418882f + 1.0f;
    f32x2 t; t.x = __builtin_amdgcn_rcpf(d.x); t.y = __builtin_amdgcn_rcpf(d.y);
    f32x2 q = t * 0.5307027145f + (-0.7265760135f); q = q * t + 0.7107068705f; q = q * t + (-0.142248368f); q = q * t + 0.127414796f; q = q * t;
    const f32x2 s = (v * v) * (-0.72134752044f);
    f32x2 e; e.x = __builtin_amdgcn_exp2f(s.x); e.y = __builtin_amdgcn_exp2f(s.y);
    const f32x2 m = v * (q * e), r = v - m;
    f32x2 o; o.x = v.x < 0.f ? m.x : r.x; o.y = v.y < 0.f ? m.y : r.y; return o;
}

constexpr int ML_ROWS = 32768;
struct EpiIn {
    static constexpr bool PERM = true, AFTER_DRAIN = false;
    bf16_t* AO; bf16_t* PM; bf16_t* RAW; float* gates; const float* bg;
    __device__ __forceinline__ void operator()(const f32x4 (&acc)[2][2][4][2], const Unit& u, int wr, int wc, int fr, int fq) const {
        const int row0 = u.pm * BM + wr * 64 + fr;
        if (u.pn < 11) {
            bf16_t* base; int ldc, colt;
            if (u.pn < 3) { base = AO; ldc = 1024; colt = u.pn * 256; } else if (u.pn < 7) { base = RAW; ldc = 1024; colt = (u.pn - 3) * 256; } else { base = PM; ldc = 2048; colt = (u.pn - 3) * 256; }
            const int col0 = colt + wc * 32 + 8 * fq;
#pragma unroll
            for (int ai = 0; ai < 2; ++ai)
#pragma unroll
                for (int m = 0; m < 4; ++m) { bf16_t* rowp = base + (size_t)(row0 + ai * HALF + m * 16) * ldc + col0;
#pragma unroll
                    for (int bj = 0; bj < 2; ++bj) { const f32x4 v0 = acc[ai][bj][m][0], v1 = acc[ai][bj][m][1];
                        u32x4 w; w.x = cvt_pk_bf16(v0[0], v0[1]); w.y = cvt_pk_bf16(v0[2], v0[3]); w.z = cvt_pk_bf16(v1[0], v1[1]); w.w = cvt_pk_bf16(v1[2], v1[3]);
                        *(u32x4*)(rowp + bj * HALF) = w; } }
        } else {
            if (wc == 0 && fq < 2) {
                const f32x4 b0 = *(const f32x4*)(bg + 8 * fq), b1 = *(const f32x4*)(bg + 8 * fq + 4);
#pragma unroll
                for (int ai = 0; ai < 2; ++ai)
#pragma unroll
                    for (int m = 0; m < 4; ++m) { float* rowp = gates + (size_t)(row0 + ai * HALF + m * 16) * 16 + 8 * fq;
                        *(f32x4*)(rowp) = acc[ai][0][m][0] + b0; *(f32x4*)(rowp + 4) = acc[ai][0][m][1] + b1; }
            }
        }
    }
};
struct EpiRes {
    static constexpr bool PERM = true, AFTER_DRAIN = false;
    const void* xlat; const void* xctx; bf16_t* X; const float* gmod; unsigned rowmask; bf16_t* PART; int xbf;
    __device__ __forceinline__ void operator()(const f32x4 (&acc)[2][2][4][2], const Unit& u, int wr, int wc, int fr, int fq) const {
        const int row0 = u.pm * BM + wr * 64 + fr;
        const int mr = (u.pm < 128) ? (u.pm >> 4) : 8;
        const int col0 = u.pn * BM + wc * 32 + 8 * fq;
        const float* gp = gmod + (size_t)mr * 6144 + col0;
        if (u.sl >= 0) {
            bf16_t* pp = PART + ((size_t)u.sl * 2048 + (row0 - ML_ROWS)) * 1024 + col0;
#pragma unroll
            for (int ai = 0; ai < 2; ++ai)
#pragma unroll
                for (int m = 0; m < 4; ++m)
#pragma unroll
                    for (int bj = 0; bj < 2; ++bj) { bf16_t* q = pp + (size_t)(ai * HALF + m * 16) * 1024 + bj * HALF; const f32x4 v0 = acc[ai][bj][m][0], v1 = acc[ai][bj][m][1];
                        u32x4 w; w.x = cvt_pk_bf16(v0[0], v0[1]); w.y = cvt_pk_bf16(v0[2], v0[3]); w.z = cvt_pk_bf16(v1[0], v1[1]); w.w = cvt_pk_bf16(v1[2], v1[3]); *(u32x4*)q = w; }
            return;
        }
        f32x4 gv[2][2];
#pragma unroll
        for (int bj = 0; bj < 2; ++bj) { gv[bj][0] = *(const f32x4*)(gp + bj * HALF); gv[bj][1] = *(const f32x4*)(gp + bj * HALF + 4); }
        if (xbf) {
#pragma unroll
            for (int ai = 0; ai < 2; ++ai)
#pragma unroll
                for (int mp = 0; mp < 2; ++mp) {
                    u32x4 xr[2][2];
#pragma unroll
                    for (int mm = 0; mm < 2; ++mm) { const int row = row0 + ai * HALF + (2 * mp + mm) * 16;
                        const size_t rin = (row < ML_ROWS) ? (size_t)row : (size_t)(row - ML_ROWS);
                        const char* xin = (const char*)((row < ML_ROWS) ? xlat : xctx);
#pragma unroll
                        for (int bj = 0; bj < 2; ++bj) xr[mm][bj] = *(const u32x4*)(xin + (rin * 1024 + col0 + bj * HALF) * 2); }
#pragma unroll
                    for (int mm = 0; mm < 2; ++mm) { const int m = 2 * mp + mm; const int row = row0 + ai * HALF + m * 16;
                        bf16_t* xo = X + (size_t)((unsigned)row & rowmask) * 1024;
#pragma unroll
                        for (int bj = 0; bj < 2; ++bj) { const int c = col0 + bj * HALF; const u32x4 w = xr[mm][bj];
                            const f32x4 a0 = (f32x4){__builtin_bit_cast(float, w.x << 16), __builtin_bit_cast(float, w.x & 0xffff0000u), __builtin_bit_cast(float, w.y << 16), __builtin_bit_cast(float, w.y & 0xffff0000u)};
                            const f32x4 a1 = (f32x4){__builtin_bit_cast(float, w.z << 16), __builtin_bit_cast(float, w.z & 0xffff0000u), __builtin_bit_cast(float, w.w << 16), __builtin_bit_cast(float, w.w & 0xffff0000u)};
                            const f32x4 x0 = a0 + gv[bj][0] * acc[ai][bj][m][0], x1 = a1 + gv[bj][1] * acc[ai][bj][m][1];
                            u32x4 o; o.x = cvt_pk_bf16(x0[0], x0[1]); o.y = cvt_pk_bf16(x0[2], x0[3]); o.z = cvt_pk_bf16(x1[0], x1[1]); o.w = cvt_pk_bf16(x1[2], x1[3]);
                            *(u32x4*)(xo + c) = o; } }
                    asm volatile("" ::: "memory");
                }
        } else {
#pragma unroll
            for (int ai = 0; ai < 2; ++ai)
#pragma unroll
                for (int m = 0; m < 4; ++m) { const int row = row0 + ai * HALF + m * 16;
                    const size_t rin = (row < ML_ROWS) ? (size_t)row : (size_t)(row - ML_ROWS);
                    const char* xin = (const char*)((row < ML_ROWS) ? xlat : xctx);
                    bf16_t* xo = X + (size_t)((unsigned)row & rowmask) * 1024;
#pragma unroll
                    for (int bj = 0; bj < 2; ++bj) { const int c = col0 + bj * HALF;
                        const f32x4 a0 = *(const f32x4*)(xin + (rin * 1024 + c) * 4), a1 = *(const f32x4*)(xin + (rin * 1024 + c) * 4 + 16);
                        const f32x4 x0 = a0 + gv[bj][0] * acc[ai][bj][m][0], x1 = a1 + gv[bj][1] * acc[ai][bj][m][1];
                        u32x4 o; o.x = cvt_pk_bf16(x0[0], x0[1]); o.y = cvt_pk_bf16(x0[2], x0[3]); o.z = cvt_pk_bf16(x1[0], x1[1]); o.w = cvt_pk_bf16(x1[2], x1[3]);
                        *(u32x4*)(xo + c) = o; } }
        }
    }
};
struct EpiUp {
    static constexpr bool PERM = true, AFTER_DRAIN = false;
    bf16_t* H;
    __device__ __forceinline__ void operator()(const f32x4 (&acc)[2][2][4][2], const Unit& u, int wr, int wc, int fr, int fq) const {
        const int row0 = u.pm * BM + wr * 64 + fr; const int col0 = u.pn * BM + wc * 32 + 8 * fq;
#pragma unroll
        for (int ai = 0; ai < 2; ++ai)
#pragma unroll
            for (int m = 0; m < 4; ++m) { const int row = row0 + ai * HALF + m * 16;
                bf16_t* rowp = H + ((size_t)((row >> 8) * 64 + (col0 >> 6)) * 256 + (row & 255)) * 64 + (col0 & 63);
#pragma unroll
                for (int bj = 0; bj < 2; ++bj) { f32x4 v0 = acc[ai][bj][m][0], v1 = acc[ai][bj][m][1];
#pragma unroll
                    for (int e = 0; e < 4; ++e) { const float a = fmaxf(v0[e], 0.f), b = fmaxf(v1[e], 0.f); v0[e] = a * a; v1[e] = b * b; }
                    u32x4 w; w.x = cvt_pk_bf16(v0[0], v0[1]); w.y = cvt_pk_bf16(v0[2], v0[3]); w.z = cvt_pk_bf16(v1[0], v1[1]); w.w = cvt_pk_bf16(v1[2], v1[3]);
                    __builtin_nontemporal_store(w, (u32x4*)(rowp + (size_t)bj * 2 * 256 * 64)); } }
    }
};
template <class Epi, class Sched, bool ALIGN_EPI = false, bool SP2 = false, int THIN_PN = -1>
__device__ __forceinline__ void gemm_phase(PG8_LAS unsigned char* lds, const Gemm g, const Sched& S, const Epi& E) {
    const int tid = opaque_tid(), wid = __builtin_amdgcn_readfirstlane(tid >> 6), lane = tid & 63, wr = wid >> 2, wc = wid & 3, fr = lane & 15, fq = lane >> 4;
    const int K = g.K;
    unsigned voffA[2], voffB[2];
#pragma unroll
    for (int i = 0; i < 2; ++i) { int R, C; stage_rc(tid * 16 + i * 8192, R, C); const int Rb = Epi::PERM ? ((R & ~31) + perm32(R & 31)) : R;
        voffA[i] = (unsigned)(R * (g.ablk ? BK : K) + C) * 2u; voffB[i] = (unsigned)(Rb * K + C) * 2u; }
    const size_t kstep = (size_t)(BK * 2);
    const size_t hstep = (size_t)HALF * K * 2;
    const size_t tstep = 2 * hstep;
    const size_t kstepA = g.ablk ? (size_t)BM * BK * 2 : kstep, hstepA = g.ablk ? (size_t)HALF * BK * 2 : hstep;
    const unsigned ldsw = (unsigned)wid * 1024u;
    const int aoff = lds_byte(wr * 64 + fr, fq * 8), boff = lds_byte(wc * 32 + fr, fq * 8);
#define PG8_SA(b, h) (((b) * 2 + (h)) * HTB)
#define PG8_SB(b, h) ((4 + (b) * 2 + (h)) * HTB)
#define PG8_STAGE(bufoff, gbase, voff) do { _Pragma("unroll") for (int _i = 0; _i < 2; ++_i) \
        __builtin_amdgcn_global_load_lds((const unsigned*)((const char*)(gbase) + (voff)[_i]), (PG8_LAS unsigned*)(lds + (bufoff) + ldsw + _i * 8192), 16, 0, 0); } while (0)
#define PG8_LDA(dst, b, h) do { _Pragma("unroll") for (int m = 0; m < 4; ++m) _Pragma("unroll") for (int k = 0; k < 2; ++k) dst[m][k] = *(const PG8_LAS bf16x8*)(lds + PG8_SA(b, h) + aoff + m * 2048 + k * 1024); } while (0)
#define PG8_LDB(dst, b, h) do { _Pragma("unroll") for (int n = 0; n < 2; ++n) _Pragma("unroll") for (int k = 0; k < 2; ++k) dst[n][k] = *(const PG8_LAS bf16x8*)(lds + PG8_SB(b, h) + boff + n * 2048 + k * 1024); } while (0)
#define PG8_MMA(ai, bj, At, Bt) do { __builtin_amdgcn_s_setprio(1); _Pragma("unroll") for (int m = 0; m < 4; ++m) _Pragma("unroll") for (int n = 0; n < 2; ++n) _Pragma("unroll") for (int k = 0; k < 2; ++k) \
        acc[ai][bj][m][n] = __builtin_amdgcn_mfma_f32_16x16x32_bf16(Bt[n][k], At[m][k], acc[ai][bj][m][n], 0, 0, 0); __builtin_amdgcn_s_setprio(0); } while (0)
#define PG8_MMAT(ai, bj, At, Bt) do { if (THIN_PN < 0 || !(thin && ((bj) != 0 || wc != 0))) PG8_MMA(ai, bj, At, Bt); } while (0)
#define PG8_WAIT_V(n) asm volatile("s_waitcnt vmcnt(" #n ")" ::: "memory")
#define PG8_WAIT_L(n) asm volatile("s_waitcnt lgkmcnt(" #n ")" ::: "memory")
#define PG8_BAR __builtin_amdgcn_s_barrier()
#define PG8_SCHED __builtin_amdgcn_sched_barrier(0)
    Unit cur, nxt; int ui = 0;
    if (!S.next(0, cur)) return;
    f32x4 acc[2][2][4][2];
#pragma unroll
    for (int a = 0; a < 2; ++a)
#pragma unroll
        for (int b = 0; b < 2; ++b)
#pragma unroll
            for (int m = 0; m < 4; ++m)
#pragma unroll
                for (int n = 0; n < 2; ++n) acc[a][b][m][n] = (f32x4){0.f, 0.f, 0.f, 0.f};
    bf16x8 At[4][2], B0[2][2], B1[2][2];
    const char* cA = (const char*)g.A + (size_t)cur.pm * tstep + (size_t)(cur.k0 / BK) * kstepA; const char* cB = (const char*)g.Bt + (size_t)cur.pn * tstep + (size_t)cur.k0 * 2;
    S.a_ready(cur);
    if constexpr (SP2) {
        PG8_STAGE(PG8_SB(0, 0), cB, voffB); PG8_STAGE(PG8_SB(0, 1), cB + hstep, voffB); PG8_STAGE(PG8_SA(0, 0), cA, voffA); PG8_STAGE(PG8_SA(0, 1), cA + hstepA, voffA);
        if (wr == 1) PG8_BAR;
        PG8_WAIT_V(2); PG8_BAR;
        PG8_STAGE(PG8_SB(1, 0), cB + kstep, voffB); PG8_STAGE(PG8_SA(1, 0), cA + kstepA, voffA); PG8_STAGE(PG8_SB(1, 1), cB + hstep + kstep, voffB);
        PG8_WAIT_V(6); PG8_BAR;
    } else {
        PG8_STAGE(PG8_SB(0, 0), cB, voffB); PG8_STAGE(PG8_SA(0, 0), cA, voffA); PG8_STAGE(PG8_SB(0, 1), cB + hstep, voffB); PG8_STAGE(PG8_SA(0, 1), cA + hstepA, voffA);
        if (wr == 1) PG8_BAR;
        PG8_WAIT_V(4); PG8_BAR;
        PG8_STAGE(PG8_SB(1, 0), cB + kstep, voffB); PG8_STAGE(PG8_SA(1, 0), cA + kstepA, voffA); PG8_STAGE(PG8_SB(1, 1), cB + hstep + kstep, voffB);
        PG8_WAIT_V(6); PG8_BAR;
    }
    for (;;) {
        const bool has_next = S.next(ui + 1, nxt);
        const char* nA = has_next ? (const char*)g.A + (size_t)nxt.pm * tstep + (size_t)(nxt.k0 / BK) * kstepA : cA; const char* nB = has_next ? (const char*)g.Bt + (size_t)nxt.pn * tstep + (size_t)nxt.k0 * 2 : cB;
        const int nt = cur.nt;
        const bool thin = (THIN_PN >= 0) && (cur.pn == THIN_PN);
        for (int t = 0; t < nt; t += 2) {
            const bool last = (t == nt - 2);
            const char* a1 = cA + (size_t)(t + 1) * kstepA;
            const char* a2 = last ? nA : cA + (size_t)(t + 2) * kstepA; const char* b2 = last ? nB : cB + (size_t)(t + 2) * kstep;
            const char* a3 = a2 + kstepA; const char* b3 = b2 + kstep;
            if (last && has_next) S.a_ready(nxt);
            if constexpr (SP2) {
            PG8_LDB(B0, 0, 0); PG8_LDB(B1, 0, 1); PG8_SCHED; PG8_LDA(At, 0, 0); PG8_STAGE(PG8_SA(1, 1), a1 + hstepA, voffA);
            PG8_WAIT_V(8); PG8_WAIT_L(0); PG8_BAR; PG8_MMAT(0, 0, At, B0); PG8_MMAT(0, 1, At, B1); PG8_BAR; PG8_SCHED;
            PG8_LDA(At, 0, 1); PG8_STAGE(PG8_SB(0, 0), b2, voffB); PG8_STAGE(PG8_SB(0, 1), b2 + hstep, voffB); PG8_STAGE(PG8_SA(0, 0), a2, voffA);
            PG8_WAIT_V(8); PG8_WAIT_L(0); PG8_BAR; PG8_MMAT(1, 0, At, B0); PG8_MMAT(1, 1, At, B1); PG8_BAR; PG8_SCHED;
            PG8_LDB(B0, 1, 0); PG8_LDB(B1, 1, 1); PG8_SCHED; PG8_LDA(At, 1, 0); PG8_STAGE(PG8_SA(0, 1), a2 + hstepA, voffA);
            PG8_WAIT_V(8); PG8_WAIT_L(0); PG8_BAR; PG8_MMAT(0, 0, At, B0); PG8_MMAT(0, 1, At, B1); PG8_BAR; PG8_SCHED;
            PG8_LDA(At, 1, 1); PG8_STAGE(PG8_SB(1, 0), b3, voffB); PG8_STAGE(PG8_SB(1, 1), b3 + hstep, voffB); PG8_STAGE(PG8_SA(1, 0), a3, voffA);
            PG8_WAIT_V(8); PG8_WAIT_L(0); PG8_BAR; PG8_MMAT(1, 0, At, B0); PG8_MMAT(1, 1, At, B1); PG8_BAR; PG8_SCHED;
            } else {
            PG8_LDB(B0, 0, 0); PG8_SCHED; PG8_LDA(At, 0, 0); PG8_STAGE(PG8_SA(1, 1), a1 + hstepA, voffA);
            PG8_WAIT_L(8); PG8_BAR; PG8_WAIT_L(0); PG8_MMAT(0, 0, At, B0); PG8_BAR; PG8_SCHED;
            PG8_LDB(B1, 0, 1); PG8_STAGE(PG8_SB(0, 0), b2, voffB);
            PG8_BAR; PG8_WAIT_L(0); PG8_MMAT(0, 1, At, B1); PG8_BAR;
            PG8_LDA(At, 0, 1); PG8_STAGE(PG8_SA(0, 0), a2, voffA);
            PG8_BAR; PG8_WAIT_L(0); PG8_MMAT(1, 0, At, B0); PG8_BAR; PG8_SCHED;
            PG8_STAGE(PG8_SB(0, 1), b2 + hstep, voffB);
            PG8_WAIT_V(6); PG8_BAR; PG8_MMAT(1, 1, At, B1); PG8_BAR;
            PG8_LDB(B0, 1, 0); PG8_SCHED; PG8_LDA(At, 1, 0); PG8_STAGE(PG8_SA(0, 1), a2 + hstepA, voffA);
            PG8_WAIT_L(8); PG8_BAR; PG8_WAIT_L(0); PG8_MMAT(0, 0, At, B0); PG8_BAR; PG8_SCHED;
            PG8_LDB(B1, 1, 1); PG8_STAGE(PG8_SB(1, 0), b3, voffB);
            PG8_BAR; PG8_WAIT_L(0); PG8_MMAT(0, 1, At, B1); PG8_BAR;
            PG8_LDA(At, 1, 1); PG8_STAGE(PG8_SA(1, 0), a3, voffA);
            PG8_BAR; PG8_WAIT_L(0); PG8_MMAT(1, 0, At, B0); PG8_BAR; PG8_SCHED;
            PG8_STAGE(PG8_SB(1, 1), b3 + hstep, voffB);
            PG8_WAIT_V(6); PG8_BAR; PG8_MMAT(1, 1, At, B1); PG8_BAR;
            }
        }
        if constexpr (ALIGN_EPI) { if (wr == 0) PG8_BAR; }
        if constexpr (!Epi::AFTER_DRAIN) { E(acc, cur, wr, wc, fr, fq); S.done(cur); }
        if (!has_next) break;
#pragma unroll
        for (int a = 0; a < 2; ++a)
#pragma unroll
            for (int b = 0; b < 2; ++b)
#pragma unroll
                for (int m = 0; m < 4; ++m)
#pragma unroll
                    for (int n = 0; n < 2; ++n) acc[a][b][m][n] = (f32x4){0.f, 0.f, 0.f, 0.f};
        cur = nxt; cA = nA; cB = nB; ++ui;
        if constexpr (ALIGN_EPI) { if (wr == 1) PG8_BAR; }
    }
    PG8_WAIT_V(0);
    if constexpr (!ALIGN_EPI) { if (wr == 0) PG8_BAR; }
    PG8_BAR;
    if constexpr (Epi::AFTER_DRAIN) { E.fused(acc, cur, wr, wc, fr, fq, lds, wid, lane); S.done(cur); }
#undef PG8_SA
#undef PG8_SB
#undef PG8_STAGE
#undef PG8_LDA
#undef PG8_LDB
#undef PG8_MMA
#undef PG8_MMAT
#undef PG8_WAIT_V
#undef PG8_WAIT_L
#undef PG8_BAR
#undef PG8_SCHED
}
}
#include <hip/hip_bf16.h>
#include <cmath>
namespace attn_body {
using bf16=__hip_bfloat16;
using bf16x8=__attribute__((ext_vector_type(8)))short;
using s16x4=__attribute__((ext_vector_type(4)))short;
using f32x16=__attribute__((ext_vector_type(16)))float;
using u32x4=__attribute__((ext_vector_type(4)))unsigned;
constexpr int D=64,QP=1024,KVP=128;
constexpr int NW=8,QBLK=32,QB=QBLK*NW,KVBLK=64;
__device__ __forceinline__ int crow(int r,int hi){return (r&3)+8*(r>>2)+4*hi;}
#define SBAR() __builtin_amdgcn_sched_barrier(0)
constexpr int NSLOT=3, SLOTB=8192;
constexpr int LDS_K=0, LDS_V=NSLOT*SLOTB, LDS_WS=2*NSLOT*SLOTB, LDS_OST=LDS_WS+NW*64*4, LDS_BYTES=LDS_OST+NW*4096;
constexpr float C2=0.125f*1.4426950408889634f;
__device__ __forceinline__ void glds16(const void*gsrc,unsigned lds_dst){unsigned keep;
  asm volatile("s_mov_b32 %0, m0\n\ts_mov_b32 m0, %2\n\ts_nop 0\n\tglobal_load_lds_dwordx4 %1, off\n\ts_mov_b32 m0, %0":"=&s"(keep):"v"(gsrc),"s"(lds_dst):"memory");}
__device__ __forceinline__ float max3f(float a,float b,float c){float r;asm("v_max3_f32 %0, %1, %2, %3":"=v"(r):"v"(a),"v"(b),"v"(c));return r;}
__device__ __forceinline__ float max2f(float a,float b){float r;asm("v_max_f32_e32 %0, %1, %2":"=v"(r):"v"(a),"v"(b));return r;}
__device__ __forceinline__ float fadd_s(float a,float b){float r;asm("v_add_f32_e32 %0, %1, %2":"=v"(r):"v"(a),"v"(b));return r;}
__device__ __forceinline__ float fsub_s(float a,float b){float r;asm("v_sub_f32_e32 %0, %1, %2":"=v"(r):"v"(a),"v"(b));return r;}
typedef float f32x2_t __attribute__((ext_vector_type(2))); typedef __bf16 bf16x2_t __attribute__((ext_vector_type(2)));
__device__ __forceinline__ unsigned cvtpk_s(float lo,float hi){f32x2_t v={lo,hi};bf16x2_t b=__builtin_convertvector(v,bf16x2_t);return __builtin_bit_cast(unsigned,b);}
#define WAIT_BAR(N) asm volatile("s_waitcnt vmcnt(" #N ") lgkmcnt(0)\n\ts_barrier":::"memory")

__device__ __forceinline__ void qkt(f32x16&p0,f32x16&p1,const char*Kslot,const bf16x8*qr,const f32x16&negm,int r32,int hi){
  const char*kb=Kslot+hi*1024+r32*16;
  #pragma unroll
  for(int d0=0;d0<4;++d0){
    const bf16x8 b0=*reinterpret_cast<const bf16x8*>(kb+d0*2048);
    const bf16x8 b1=*reinterpret_cast<const bf16x8*>(kb+d0*2048+512);
    if(d0==0){p0=__builtin_amdgcn_mfma_f32_32x32x16_bf16(b0,qr[0],negm,0,0,0);p1=__builtin_amdgcn_mfma_f32_32x32x16_bf16(b1,qr[0],negm,0,0,0);}
    else{p0=__builtin_amdgcn_mfma_f32_32x32x16_bf16(b0,qr[d0],p0,0,0,0);p1=__builtin_amdgcn_mfma_f32_32x32x16_bf16(b1,qr[d0],p1,0,0,0);}}
}
typedef __attribute__((address_space(3))) const char* lds_cptr;
typedef short v4i16_t __attribute__((ext_vector_type(4)));
__device__ __forceinline__ void kload8(bf16x8*kf,lds_cptr kp){
  kf[0]=*(const __attribute__((address_space(3))) bf16x8*)(kp);      kf[1]=*(const __attribute__((address_space(3))) bf16x8*)(kp+512);
  kf[2]=*(const __attribute__((address_space(3))) bf16x8*)(kp+2048); kf[3]=*(const __attribute__((address_space(3))) bf16x8*)(kp+2560);
  kf[4]=*(const __attribute__((address_space(3))) bf16x8*)(kp+4096); kf[5]=*(const __attribute__((address_space(3))) bf16x8*)(kp+4608);
  kf[6]=*(const __attribute__((address_space(3))) bf16x8*)(kp+6144); kf[7]=*(const __attribute__((address_space(3))) bf16x8*)(kp+6656);
}
__device__ __forceinline__ void kload2(bf16x8*kf,lds_cptr kp,int j){ kf[2*j]=*(const __attribute__((address_space(3))) bf16x8*)(kp+j*2048); kf[2*j+1]=*(const __attribute__((address_space(3))) bf16x8*)(kp+j*2048+512); }
__device__ __forceinline__ s16x4 vtr(lds_cptr p){ return __builtin_bit_cast(s16x4,__builtin_amdgcn_ds_read_tr16_b64_v4i16((__attribute__((address_space(3))) v4i16_t*)p)); }
__device__ __forceinline__ float rowmax(const f32x16&p0,const f32x16&p1){
  float a=max3f(p0[0],p0[1],p1[0]),b=max3f(p0[2],p0[3],p1[1]);a=max3f(a,p1[2],p1[3]);
  #pragma unroll
  for(int r=4;r<16;r+=4){a=max3f(a,p0[r],p0[r+1]);b=max3f(b,p0[r+2],p0[r+3]);a=max3f(a,p1[r],p1[r+1]);b=max3f(b,p1[r+2],p1[r+3]);}
  const float m=max2f(a,b);
  auto rr=__builtin_amdgcn_permlane32_swap(__float_as_uint(m),__float_as_uint(m),false,false);
  return max2f(__uint_as_float(rr[0]),__uint_as_float(rr[1]));
}
__device__ __forceinline__ void pv(f32x16*o,int vb,bf16x8 pa0,bf16x8 pa1,bf16x8 pa2,bf16x8 pa3){
  #pragma unroll
  for(int d0=0;d0<2;++d0){s16x4 lo[4],hi[4];
    #pragma unroll
    for(int ks=0;ks<4;++ks){
      asm volatile("ds_read_b64_tr_b16 %0,%1 offset:%c2":"=&v"(lo[ks]):"v"(vb),"i"(d0*4096+ks*1024):"memory");
      asm volatile("ds_read_b64_tr_b16 %0,%1 offset:%c2":"=&v"(hi[ks]):"v"(vb),"i"(d0*4096+ks*1024+512):"memory");}
    asm volatile("s_waitcnt lgkmcnt(0)":::"memory");SBAR();
    #define PK(k) (bf16x8){lo[k][0],lo[k][1],lo[k][2],lo[k][3],hi[k][0],hi[k][1],hi[k][2],hi[k][3]}
    o[d0]=__builtin_amdgcn_mfma_f32_32x32x16_bf16(pa0,PK(0),o[d0],0,0,0);
    o[d0]=__builtin_amdgcn_mfma_f32_32x32x16_bf16(pa1,PK(1),o[d0],0,0,0);
    o[d0]=__builtin_amdgcn_mfma_f32_32x32x16_bf16(pa2,PK(2),o[d0],0,0,0);
    o[d0]=__builtin_amdgcn_mfma_f32_32x32x16_bf16(pa3,PK(3),o[d0],0,0,0);
    #undef PK
  }
}

#ifndef ATTN_STORE16
#define ATTN_STORE16(p,v) (*(u32x4*)(p)=(v))
#endif
template<int THRL> __device__ __forceinline__ void attn_unit(bf16*Qu,bf16*Ou,const bf16*__restrict__ Kh,const bf16*__restrict__ Vh,const int NT,char*shm){
  const int tid=opaque_tid(),lane=tid&63,r32=lane&31,hi=lane>>5; const int wid=__builtin_amdgcn_readfirstlane(tid>>6);
  const bf16*Qw=Qu+(long)(wid*QBLK)*QP;
  const unsigned lds0=(unsigned)(uintptr_t)shm;
  float*wsf=(float*)(shm+LDS_WS)+wid*64;
  const bf16*ksrc=Kh+(long)lane*KVP+wid*8;
  const bf16*vsrc=Vh+(long)(16*(wid&3)+(lane>>2))*KVP+(wid>>2)*32+(lane&3)*8;
  const unsigned kdst=lds0+LDS_K+wid*1024, vdst=lds0+LDS_V+wid*1024;
  #define DMA_K(t,slot) glds16(ksrc+(long)(t)*KVBLK*KVP,(unsigned)__builtin_amdgcn_readfirstlane(kdst+(slot)))
  #define DMA_V(t,slot) glds16(vsrc+(long)(t)*KVBLK*KVP,(unsigned)__builtin_amdgcn_readfirstlane(vdst+(slot)))
  const int vb0=(int)(lds0+LDS_V)+((lane>>4)&1)*32+(lane&3)*8+(4*hi+((lane&15)>>2))*64;
  const char*Kbase=shm+LDS_K; bf16x8 kf[8];
  const lds_cptr shm3=(lds_cptr)shm; const lds_cptr kp0=shm3+LDS_K+hi*1024+r32*16; const lds_cptr vp0=shm3+LDS_V+((lane>>4)&1)*32+(lane&3)*8+(4*hi+((lane&15)>>2))*64;
  DMA_K(0,0);DMA_V(0,0);DMA_K(1,SLOTB);
  bf16x8 qr[4];
  #pragma unroll
  for(int d0=0;d0<4;++d0)qr[d0]=*reinterpret_cast<const bf16x8*>(&Qw[(long)r32*QP+d0*16+hi*8]);
  float mhat=0.f,l_reg=0.f;f32x16 o[2];o[0]=f32x16{};o[1]=f32x16{};f32x16 negm=f32x16{};asm volatile("":"+v"(negm));
  #define CMASK(P0,P1,t) do{}while(0)
  bool resc=false;
  #define START(P0,P1) do{ const float rm=rowmax(P0,P1); resc=false; \
    { const float dl=rm; mhat=fadd_s(mhat,dl); \
      _Pragma("unroll") for(int r=0;r<16;++r){P0[r]=fsub_s(P0[r],dl);P1[r]=fsub_s(P1[r],dl);} \
      _Pragma("unroll") for(int r=0;r<16;++r)negm[r]=-mhat; asm volatile("":"+v"(negm)); } \
    _Pragma("unroll") for(int r=0;r<16;++r)P0[r]=__builtin_amdgcn_exp2f(P0[r]); }while(0)
  #define RESC() do{ if(resc){ asm volatile("s_waitcnt lgkmcnt(0)":::"memory"); \
      _Pragma("unroll") for(int d_=0;d_<2;++d_) _Pragma("unroll") for(int r=0;r<16;++r)o[d_][r]*=wsf[crow(r,hi)]; } }while(0)
  f32x16 pA0,pA1,pB0,pB1;
  int sl_prev=0,sl_cur=0,sl_next=SLOTB;
  #define ROT() do{sl_prev=sl_cur;sl_cur=sl_next;sl_next=(sl_next==(NSLOT-1)*SLOTB)?0:sl_next+SLOTB;}while(0)
  DMA_K(2,2*SLOTB);
  WAIT_BAR(3);
  qkt(pA0,pA1,Kbase,qr,negm,r32,hi);asm volatile("s_nop 15\n\ts_nop 7":"+v"(pA0),"+v"(pA1));CMASK(pA0,pA1,0);
  START(pA0,pA1);
  _Pragma("unroll") for(int r=0;r<16;++r)pA1[r]=__builtin_amdgcn_exp2f(pA1[r]);
  WAIT_BAR(0);
  DMA_K(3,0);DMA_V(1,SLOTB);
  ROT();
  kload8(kf,kp0+sl_cur);
  WAIT_BAR(2);
  s16x4 vlo[8],vhi[8]; u32x4 pw0,pw1,pw2,pw3;
  #define PKW(P,B) cvtpk_s(P[B],P[B+1])
  #define PAF(k) __builtin_bit_cast(bf16x8,pw##k)
  #define VFR(i) (bf16x8){vlo[i][0],vlo[i][1],vlo[i][2],vlo[i][3],vhi[i][0],vhi[i][1],vhi[i][2],vhi[i][3]}
  #define PIN(x) asm volatile("":"+v"(x))
  #define MX3(a,b,c) __builtin_fmaxf(__builtin_fmaxf((a),(b)),(c))
  #define GAPA(MF,A0,A1,A2,A3,W0,W1,PW) do{ MF; sacc+=A0; sacc+=A1; sacc+=A2; sacc+=A3; PIN(sacc); W0; W1; PIN(PW); SBAR(); }while(0)
  #define EX(v) __builtin_amdgcn_exp2f(v)
  #define GAPB(MF,X,B) do{ MF; X[B]=EX(X[B]); X[B+1]=EX(X[B+1]); X[B+2]=EX(X[B+2]); X[B+3]=EX(X[B+3]); PIN(X); SBAR(); }while(0)
  #define VRD(i) do{ vlo[i]=vtr(vp_+(((i)>>2)*4096+((i)&3)*1024)); vhi[i]=vtr(vp_+(((i)>>2)*4096+((i)&3)*1024+512)); }while(0)
  #define KRD(G,j) do{ if(G){ kload2(kf,kp0+sl_next,j); SBAR(); } }while(0)
  #define STEP(C0,C1,P0,P1,t,GK,GV,GL) do{ SBAR(); \
    const lds_cptr vp_=vp0+sl_prev; \
    VRD(0); SBAR(); float sacc=(P0[0]+P0[1]); \
    GAPA(C0=__builtin_amdgcn_mfma_f32_32x32x16_bf16(kf[0],qr[0],negm,0,0,0), P0[2],P0[3],P0[4],P0[5],     pw0[0]=PKW(P0,0), pw0[1]=PKW(P0,2), pw0); \
    VRD(4); SBAR(); GAPA(C1=__builtin_amdgcn_mfma_f32_32x32x16_bf16(kf[1],qr[0],negm,0,0,0), P0[6],P0[7],P0[8],P0[9],     pw0[2]=PKW(P0,4), pw0[3]=PKW(P0,6), pw0); \
    VRD(1); SBAR(); GAPA(C0=__builtin_amdgcn_mfma_f32_32x32x16_bf16(kf[2],qr[1],C0,0,0,0),   P0[10],P0[11],P0[12],P0[13], pw1[0]=PKW(P0,8), pw1[1]=PKW(P0,10), pw1); \
    VRD(5); SBAR(); GAPA(C1=__builtin_amdgcn_mfma_f32_32x32x16_bf16(kf[3],qr[1],C1,0,0,0),   P0[14],P0[15],P1[0],P1[1],   pw1[2]=PKW(P0,12),pw1[3]=PKW(P0,14), pw1); \
    VRD(2); SBAR(); GAPA(C0=__builtin_amdgcn_mfma_f32_32x32x16_bf16(kf[4],qr[2],C0,0,0,0),   P1[2],P1[3],P1[4],P1[5],     pw2[0]=PKW(P1,0), pw2[1]=PKW(P1,2), pw2); \
    VRD(6); SBAR(); GAPA(C1=__builtin_amdgcn_mfma_f32_32x32x16_bf16(kf[5],qr[2],C1,0,0,0),   P1[6],P1[7],P1[8],P1[9],     pw2[2]=PKW(P1,4), pw2[3]=PKW(P1,6), pw2); \
    VRD(3); SBAR(); GAPA(C0=__builtin_amdgcn_mfma_f32_32x32x16_bf16(kf[6],qr[3],C0,0,0,0),   P1[10],P1[11],P1[12],P1[13], pw3[0]=PKW(P1,8), pw3[1]=PKW(P1,10), pw3); \
    VRD(7); SBAR(); GAPA(C1=__builtin_amdgcn_mfma_f32_32x32x16_bf16(kf[7],qr[3],C1,0,0,0),   P1[14],P1[15],0.f,0.f,       pw3[2]=PKW(P1,12),pw3[3]=PKW(P1,14), pw3); \
    l_reg+=sacc; \
    if(GK){DMA_K((t)+3,sl_cur);} if(GV){DMA_V((t)+1,sl_next);} \
    CMASK(C0,C1,t); \
    { float a=MX3(C0[0],C0[1],C1[0]),b=MX3(C0[2],C0[3],C1[1]); a=MX3(a,C1[2],C1[3]); \
      _Pragma("unroll") for(int r=4;r<16;r+=4){a=MX3(a,C0[r],C0[r+1]);b=MX3(b,C0[r+2],C0[r+3]);a=MX3(a,C1[r],C1[r+1]);b=MX3(b,C1[r+2],C1[r+3]);} \
      float rm=__builtin_fmaxf(a,b); { auto rr=__builtin_amdgcn_permlane32_swap(__float_as_uint(rm),__float_as_uint(rm),false,false); rm=__builtin_fmaxf(__uint_as_float(rr[0]),__uint_as_float(rr[1])); } \
      resc=false; \
      if(__builtin_expect(__any(rm>(float)THRL),0)){ const float dl=__builtin_fmaxf(rm,0.f); mhat+=dl; \
        _Pragma("unroll") for(int r=0;r<16;++r){C0[r]-=dl;C1[r]-=dl;} \
        _Pragma("unroll") for(int r=0;r<16;++r)negm[r]=-mhat; asm volatile("":"+v"(negm)); \
        const float f=__builtin_amdgcn_exp2f(-dl); l_reg*=f; if(hi==0)wsf[r32]=f; resc=true; } } \
    SBAR(); \
    GAPB(o[0]=__builtin_amdgcn_mfma_f32_32x32x16_bf16(PAF(0),VFR(0),o[0],0,0,0), C0,0); \
    GAPB(o[1]=__builtin_amdgcn_mfma_f32_32x32x16_bf16(PAF(0),VFR(4),o[1],0,0,0), C0,4); \
    KRD(GL,0); GAPB(o[0]=__builtin_amdgcn_mfma_f32_32x32x16_bf16(PAF(1),VFR(1),o[0],0,0,0), C0,8); \
    KRD(GL,1); GAPB(o[1]=__builtin_amdgcn_mfma_f32_32x32x16_bf16(PAF(1),VFR(5),o[1],0,0,0), C0,12); \
    KRD(GL,2); GAPB(o[0]=__builtin_amdgcn_mfma_f32_32x32x16_bf16(PAF(2),VFR(2),o[0],0,0,0), C1,0); \
    KRD(GL,3); GAPB(o[1]=__builtin_amdgcn_mfma_f32_32x32x16_bf16(PAF(2),VFR(6),o[1],0,0,0), C1,4); \
    GAPB(o[0]=__builtin_amdgcn_mfma_f32_32x32x16_bf16(PAF(3),VFR(3),o[0],0,0,0), C1,8); \
    GAPB(o[1]=__builtin_amdgcn_mfma_f32_32x32x16_bf16(PAF(3),VFR(7),o[1],0,0,0), C1,12); \
    }while(0)
  int t=1;
  #undef CMASK
  #define CMASK(P0,P1,t) do{}while(0)
  for(;t+5<NT;t+=2){
    STEP(pB0,pB1,pA0,pA1,t,true,true,true);     WAIT_BAR(2); RESC(); ROT();
    STEP(pA0,pA1,pB0,pB1,t+1,true,true,true);   WAIT_BAR(2); RESC(); ROT();
  }
  #undef CMASK
  #define CMASK(P0,P1,t) do{}while(0)
  #define ENDW(tt) do{ if((tt)+3<NT){WAIT_BAR(2);} else if((tt)+2<NT){WAIT_BAR(1);} else {WAIT_BAR(0);} }while(0)
  for(;t+1<NT;t+=2){
    STEP(pB0,pB1,pA0,pA1,t,(t+3<NT),(t+1<NT),(t+1<NT));       ENDW(t);   RESC(); ROT();
    STEP(pA0,pA1,pB0,pB1,t+1,(t+4<NT),(t+2<NT),(t+2<NT));     ENDW(t+1); RESC(); ROT();
  }
  STEP(pB0,pB1,pA0,pA1,NT-1,false,false,false); RESC();
  { float sacc=pB0[0]+pB0[1]; _Pragma("unroll") for(int r=2;r<16;++r)sacc+=pB0[r]; _Pragma("unroll") for(int r=0;r<16;++r)sacc+=pB1[r]; l_reg+=sacc;
    pw0=(u32x4){PKW(pB0,0),PKW(pB0,2),PKW(pB0,4),PKW(pB0,6)};pw1=(u32x4){PKW(pB0,8),PKW(pB0,10),PKW(pB0,12),PKW(pB0,14)};pw2=(u32x4){PKW(pB1,0),PKW(pB1,2),PKW(pB1,4),PKW(pB1,6)};pw3=(u32x4){PKW(pB1,8),PKW(pB1,10),PKW(pB1,12),PKW(pB1,14)};
    SBAR(); pv(o,vb0+sl_cur,PAF(0),PAF(1),PAF(2),PAF(3)); }
  #undef PKW
  #undef PAF
  #undef VFR
  #undef PIN
  #undef MX3
  #undef GAPA
  #undef GAPB
  #undef EX
  #undef VRD
  #undef KRD
  #undef STEP
  #undef ENDW
  {auto rr=__builtin_amdgcn_permlane32_swap(__float_as_uint(l_reg),__float_as_uint(l_reg),false,false);l_reg=__uint_as_float(rr[0])+__uint_as_float(rr[1]);}
  if(hi==0)wsf[32+r32]=l_reg;asm volatile("s_waitcnt lgkmcnt(0)":::"memory");
  float rli[16];
  #pragma unroll
  for(int r=0;r<16;++r)rli[r]=__builtin_amdgcn_rcpf(wsf[32+crow(r,hi)]);
  bf16*Ow=Ou+(long)(wid*QBLK)*QP;
  { bf16*stg=(bf16*)(shm+LDS_OST)+wid*2048;
    #pragma unroll
    for(int r=0;r<16;++r){const int orow=crow(r,hi);
      #pragma unroll
      for(int d0=0;d0<2;++d0)stg[orow*64+d0*32+r32]=__float2bfloat16(o[d0][r]*rli[r]);}
    asm volatile("s_waitcnt lgkmcnt(0)":::"memory");
    #pragma unroll
    for(int i=0;i<4;++i){const int row=i*8+(lane>>3),ch=lane&7; const u32x4 v=*(const u32x4*)(stg+row*64+ch*8); ATTN_STORE16(Ow+(long)row*QP+ch*8,v);} }
  asm volatile("s_waitcnt lgkmcnt(0)\n\ts_barrier":::"memory");
  #undef DMA_K
  #undef DMA_V
  #undef CMASK
  #undef START
  #undef RESC
  #undef ROT
}
constexpr int ATTN_LDS_BYTES=LDS_BYTES;
#undef SBAR
#undef WAIT_BAR
}
#define LAS __attribute__((address_space(3)))
typedef unsigned short bf16;
typedef unsigned v4u __attribute__((ext_vector_type(4)));
typedef unsigned v2u __attribute__((ext_vector_type(2)));
typedef float f32x4 __attribute__((ext_vector_type(4)));
typedef short bf16x8 __attribute__((ext_vector_type(8)));
typedef short bf16x4 __attribute__((ext_vector_type(4)));

constexpr int NB = 8, TL = 4096, TCX = 256, DM = 1024, DEPTH = 4, NMOD = 6;
constexpr int ML = NB * TL, MC = NB * TCX, MT = ML + MC;
constexpr int NINP = 3072, NIN = 2832;
constexpr int FF = 4096, KVLEN = TCX + TL;
constexpr float EPS = 1e-6f;
constexpr size_t MiB = 1u << 20;
constexpr size_t WS_MOD = 64 * 1024;
constexpr size_t WS_WIN = 2 * MiB, WS_WOUT = 8 * MiB, WS_W1 = 10 * MiB, WS_W2 = 18 * MiB;
constexpr size_t WS_X = 26 * MiB;
constexpr size_t WS_XN = 162 * MiB;
constexpr size_t WS_HB = WS_XN + 34 * MiB;
constexpr size_t WS_AO = 230 * MiB;
constexpr size_t WS_PM = 298 * MiB;
constexpr size_t WS_K = 434 * MiB, WS_V = 443 * MiB;
constexpr size_t WS_G = 452 * MiB;
constexpr size_t WS_H = 230 * MiB;
constexpr size_t WS_GA = 456 * MiB, WS_BP = 458 * MiB, WS_CH = 462 * MiB;
constexpr size_t WS_END = 502 * MiB;
constexpr int LDS_BYTES = 163840, TAB_OFF = 163840 - 256;
__device__ __forceinline__ unsigned long long rd_ptr(const unsigned char* lds, int k) {
    const LAS unsigned* t = (const LAS unsigned*)((const LAS unsigned char*)lds + TAB_OFF) + 2 * k; unsigned lo = t[0], hi = t[1];
    lo = __builtin_amdgcn_readfirstlane(lo); hi = __builtin_amdgcn_readfirstlane(hi); return ((unsigned long long)hi << 32) | lo; }

__device__ __forceinline__ unsigned f2bf(float f) { unsigned u = __builtin_bit_cast(unsigned, f); return (u + 0x7fffu + ((u >> 16) & 1u)) >> 16; }
__device__ __forceinline__ unsigned pk2(float lo, float hi) { return pg8::cvt_pk_bf16(lo, hi); }
__device__ __forceinline__ float bflo(unsigned w) { return __builtin_bit_cast(float, w << 16); }
__device__ __forceinline__ float bfhi(unsigned w) { return __builtin_bit_cast(float, w & 0xffff0000u); }
__device__ __forceinline__ float wave_sum(float v) {
#pragma unroll
    for (int o = 1; o < 64; o <<= 1) v += __shfl_xor(v, o);
    return v;
}
__device__ __forceinline__ float sigmoidf_(float x) { return 1.f / (1.f + __expf(-x)); }
__device__ __forceinline__ float siluf_(float x) { return x / (1.f + __expf(-x)); }
__device__ __forceinline__ float logsigmoidf_(float x) { return x < 0.f ? x - log1pf(__expf(x)) : -log1pf(__expf(-x)); }

struct Args { const float* in[18]; float* out; unsigned char* ws; };

__device__ __forceinline__ void transpose_item(const float* W, int K, int N, int NBLK, bf16* WT, float* scr, int item, int lane) {
    const int kb = item / NBLK, nb = item % NBLK, k0 = 64 * kb, n0 = 32 * nb; const int n = n0 + (lane & 31);
#pragma unroll 16
    for (int i = 0; i < 32; ++i) { const int kk = 2 * i + (lane >> 5); scr[kk * 33 + (lane & 31)] = (n < N) ? W[(size_t)(k0 + kk) * N + n] : 0.f; }
    asm volatile("s_waitcnt lgkmcnt(0)" ::: "memory");
    const int c = lane & 7;
#pragma unroll
    for (int j = 0; j < 4; ++j) { const int nn = (lane >> 3) + 8 * j; const float* s = scr + (8 * c) * 33 + nn;
        v4u o; o.x = pk2(s[0 * 33], s[1 * 33]); o.y = pk2(s[2 * 33], s[3 * 33]); o.z = pk2(s[4 * 33], s[5 * 33]); o.w = pk2(s[6 * 33], s[7 * 33]);
        *(v4u*)(WT + (size_t)(n0 + nn) * K + k0 + 8 * c) = o; }
    asm volatile("s_waitcnt lgkmcnt(0)" ::: "memory");
}

template <bool BF> __device__ __forceinline__ f32x4 ldx4(const void* row, int i) {
    if (BF) { const v2u w = ((const v2u*)row)[i]; return (f32x4){bflo(w.x), bfhi(w.x), bflo(w.y), bfhi(w.y)}; }
    else return ((const f32x4*)row)[i];
}
template <bool BF> __device__ __forceinline__ void modulate_row(const void* xrow, bf16* orow, const float* gain, const float* shift, const float* scale, int lane) {
    f32x4 v[4]; float s = 0.f;
#pragma unroll
    for (int j = 0; j < 4; ++j) { v[j] = ldx4<BF>(xrow, lane + 64 * j); s += (v[j].x * v[j].x + v[j].y * v[j].y) + (v[j].z * v[j].z + v[j].w * v[j].w); }
    const float r = rsqrtf(wave_sum(s) * (1.f / DM) + EPS);
    unsigned long long* o8 = (unsigned long long*)orow + lane;
#pragma unroll
    for (int j = 0; j < 4; ++j) { const int c = 4 * lane + 256 * j;
        const f32x4 g = *(const f32x4*)(gain + c), sh = *(const f32x4*)(shift + c), sc = *(const f32x4*)(scale + c);
        const f32x4 y = v[j] * r * g * (sc + 1.f) + sh;
        o8[64 * j] = (unsigned long long)pk2(y.x, y.y) | ((unsigned long long)pk2(y.z, y.w) << 32); }
}
template <bool BF> __device__ __forceinline__ void modulate_row2(const void* x0, bf16* o0, const float* sh0, const float* sc0, const void* x1, bf16* o1, const float* sh1, const float* sc1, const float* gain, int lane) {
    f32x4 v0[4], v1[4]; float s0 = 0.f, s1 = 0.f;
#pragma unroll
    for (int j = 0; j < 4; ++j) { v0[j] = ldx4<BF>(x0, lane + 64 * j); v1[j] = ldx4<BF>(x1, lane + 64 * j); }
#pragma unroll
    for (int j = 0; j < 4; ++j) { s0 += (v0[j].x * v0[j].x + v0[j].y * v0[j].y) + (v0[j].z * v0[j].z + v0[j].w * v0[j].w); s1 += (v1[j].x * v1[j].x + v1[j].y * v1[j].y) + (v1[j].z * v1[j].z + v1[j].w * v1[j].w); }
#pragma unroll
    for (int o = 1; o < 64; o <<= 1) { s0 += __shfl_xor(s0, o); s1 += __shfl_xor(s1, o); }
    const float r0 = rsqrtf(s0 * (1.f / DM) + EPS), r1 = rsqrtf(s1 * (1.f / DM) + EPS);
    unsigned long long* p0 = (unsigned long long*)o0 + lane; unsigned long long* p1 = (unsigned long long*)o1 + lane;
#pragma unroll
    for (int j = 0; j < 4; ++j) { const int c = 4 * lane + 256 * j;
        const f32x4 g = *(const f32x4*)(gain + c);
        const f32x4 y0 = v0[j] * r0 * g * (*(const f32x4*)(sc0 + c) + 1.f) + *(const f32x4*)(sh0 + c);
        const f32x4 y1 = v1[j] * r1 * g * (*(const f32x4*)(sc1 + c) + 1.f) + *(const f32x4*)(sh1 + c);
        p0[64 * j] = (unsigned long long)pk2(y0.x, y0.y) | ((unsigned long long)pk2(y0.z, y0.w) << 32);
        p1[64 * j] = (unsigned long long)pk2(y1.x, y1.y) | ((unsigned long long)pk2(y1.z, y1.w) << 32); }
}
template <bool BF> __device__ __forceinline__ void modulate_rows4(const void* xbase, bf16* obase, int row, int st, const float* modbase  , int shoff, int scoff, const float* gain, int lane) {
    f32x4 v[4][4]; float ss[4];
#pragma unroll
    for (int q = 0; q < 4; ++q) { const void* xr = BF ? (const void*)((const bf16*)xbase + (size_t)(row + q * st) * 1024) : (const void*)((const float*)xbase + (size_t)(row + q * st) * 1024);
#pragma unroll
        for (int j = 0; j < 4; ++j) v[q][j] = ldx4<BF>(xr, lane + 64 * j); }
#pragma unroll
    for (int q = 0; q < 4; ++q) { float a = 0.f;
#pragma unroll
        for (int j = 0; j < 4; ++j) a += (v[q][j].x * v[q][j].x + v[q][j].y * v[q][j].y) + (v[q][j].z * v[q][j].z + v[q][j].w * v[q][j].w);
        ss[q] = a; }
#pragma unroll
    for (int o = 1; o < 64; o <<= 1) {
#pragma unroll
        for (int q = 0; q < 4; ++q) ss[q] += __shfl_xor(ss[q], o); }
#pragma unroll
    for (int q = 0; q < 4; ++q) { const int r_ = row + q * st; const float r = rsqrtf(ss[q] * (1.f / DM) + EPS);
        const float* mp = modbase + (size_t)(r_ >> 12) * 6144;
        unsigned long long* p = (unsigned long long*)(obase + (size_t)r_ * 1024) + lane;
#pragma unroll
        for (int j = 0; j < 4; ++j) { const int c = 4 * lane + 256 * j;
            const f32x4 y = v[q][j] * r * *(const f32x4*)(gain + c) * (*(const f32x4*)(mp + scoff + c) + 1.f) + *(const f32x4*)(mp + shoff + c);
            p[64 * j] = (unsigned long long)pk2(y.x, y.y) | ((unsigned long long)pk2(y.z, y.w) << 32); } }
}
template <bool BF> __device__ __forceinline__ void modulate_row_part(const void* xrow, bf16* xout, const bf16* part  , const float* gate, bf16* orow, const float* gain, const float* shift, const float* scale, int lane) {
    f32x4 v[4]; float s = 0.f;
#pragma unroll
    for (int j = 0; j < 4; ++j) { f32x4 p = (f32x4){0.f, 0.f, 0.f, 0.f};
#pragma unroll
        for (int sl = 0; sl < 8; ++sl) p += ldx4<true>(part + (size_t)sl * 2048 * 1024, lane + 64 * j);
        v[j] = ldx4<BF>(xrow, lane + 64 * j) + *(const f32x4*)(gate + 4 * lane + 256 * j) * p;
        ((unsigned long long*)xout + lane)[64 * j] = (unsigned long long)pk2(v[j].x, v[j].y) | ((unsigned long long)pk2(v[j].z, v[j].w) << 32);
        s += (v[j].x * v[j].x + v[j].y * v[j].y) + (v[j].z * v[j].z + v[j].w * v[j].w); }
    const float r = rsqrtf(wave_sum(s) * (1.f / DM) + EPS);
    unsigned long long* o8 = (unsigned long long*)orow + lane;
#pragma unroll
    for (int j = 0; j < 4; ++j) { const int c = 4 * lane + 256 * j;
        const f32x4 g = *(const f32x4*)(gain + c), sh = *(const f32x4*)(shift + c), sc = *(const f32x4*)(scale + c);
        const f32x4 y = v[j] * r * g * (sc + 1.f) + sh;
        o8[64 * j] = (unsigned long long)pk2(y.x, y.y) | ((unsigned long long)pk2(y.z, y.w) << 32); }
}

#define XB_TMO      128
#define XB_XCNT(j)  (256  + 64 * (j))
#define XB_XSUB(j)  (1280 + 64 * (j))
#define XB_XGEN(j)  (2304 + 64 * (j))
#define XB_TOP      3328
#define XB_TOPGEN   3392
#define XCD_BAR_WORDS 3456
#define XB_SPIN_CAP (1u << 18)

__device__ __forceinline__ unsigned xb_ld(unsigned* p)              { return __hip_atomic_load(p, __ATOMIC_RELAXED, __HIP_MEMORY_SCOPE_AGENT); }
__device__ __forceinline__ unsigned xb_add(unsigned* p, unsigned v) { return __hip_atomic_fetch_add(p, v, __ATOMIC_RELAXED, __HIP_MEMORY_SCOPE_AGENT); }
__device__ __forceinline__ unsigned xb_xcc_id() { return (unsigned)__builtin_amdgcn_s_getreg((3 << 11) | 20) & 0xFu; }
#define XB_SPIN(cond, bar) do { unsigned _sp = 0; while (cond) { __builtin_amdgcn_s_sleep(1); \
    if ((++_sp & 255u) == 0u) { if (xb_ld(&(bar)[XB_TMO])) break; if (_sp > XB_SPIN_CAP) { atomicAdd(&(bar)[XB_TMO], 1u); break; } } } } while (0)

struct XcdBarrier {
    unsigned* bar; unsigned x;
    volatile LAS unsigned* st;
};

__device__ __forceinline__ XcdBarrier xcd_barrier_post(unsigned* bar, volatile LAS unsigned* st) {
    XcdBarrier b; b.bar = bar; b.x = xb_xcc_id(); b.st = st;
    if (threadIdx.x == 0) (void)xb_add(&bar[XB_XCNT(b.x)], 1u);
    return b;
}
__device__ __forceinline__ void xcd_barrier_complete(unsigned* bar, unsigned x, unsigned& nloc, unsigned& nx) {
    const unsigned G = gridDim.x * gridDim.y * gridDim.z;
    unsigned sum, cnt, mine, sp = 0u;
    for (;;) {
        sum = 0u; cnt = 0u; mine = 0u;
#pragma unroll
        for (unsigned j = 0; j < 16; ++j) { const unsigned c = xb_ld(&bar[XB_XCNT(j)]); sum += c; cnt += (c > 0u) ? 1u : 0u; mine = (j == x) ? c : mine; }
        if (sum == G) break;
        __builtin_amdgcn_s_sleep(1);
        if ((++sp & 255u) == 0u) { if (xb_ld(&bar[XB_TMO])) break; if (sp > XB_SPIN_CAP) { atomicAdd(&bar[XB_TMO], 1u); break; } }
    }
    nloc = mine > 0u ? mine : 1u; nx = cnt > 0u ? cnt : 1u;
}

__device__ __forceinline__ void xcd_barrier(const XcdBarrier& b) {
    asm volatile("s_waitcnt vmcnt(0)" ::: "memory");
    __syncthreads();
    if (threadIdx.x == 0) {
        unsigned* bar = b.bar;
        __builtin_amdgcn_s_waitcnt(0);
        unsigned nloc = b.st[0], nx = b.st[1];
        if (nloc == 0u) { xcd_barrier_complete(bar, b.x, nloc, nx); b.st[0] = nloc; b.st[1] = nx; }
        const unsigned old = xb_add(&bar[XB_XSUB(b.x)], 1u);
        const unsigned gen = old / nloc;
        if (old + 1u == (gen + 1u) * nloc) {
            __builtin_amdgcn_fence(__ATOMIC_RELEASE, "agent");
            asm volatile("s_waitcnt vmcnt(0)" ::: "memory");
            const unsigned og = xb_add(&bar[XB_TOP], 1u);
            const unsigned tg = og / nx;
            if (og + 1u == (tg + 1u) * nx) xb_add(&bar[XB_TOPGEN], 1u);
            else XB_SPIN(xb_ld(&bar[XB_TOPGEN]) == tg, bar);
            __builtin_amdgcn_fence(__ATOMIC_ACQUIRE, "agent");
            xb_add(&bar[XB_XGEN(b.x)], 1u);
            asm volatile("s_waitcnt vmcnt(0)" ::: "memory");
        } else {
            XB_SPIN(xb_ld(&bar[XB_XGEN(b.x)]) == gen, bar);
            __builtin_amdgcn_fence(__ATOMIC_ACQUIRE, "agent");
            asm volatile("s_waitcnt vmcnt(0)" ::: "memory");
        }
    }
    __syncthreads();
}
__device__ __forceinline__ void modulate_row2(const float* x0, bf16* o0, const float* sh0, const float* sc0, const float* x1, bf16* o1, const float* sh1, const float* sc1, const float* gain, int lane) {
    const f32x4* xr0 = (const f32x4*)x0 + lane; const f32x4* xr1 = (const f32x4*)x1 + lane;
    f32x4 v0[4], v1[4]; float s0 = 0.f, s1 = 0.f;
#pragma unroll
    for (int j = 0; j < 4; ++j) { v0[j] = xr0[64 * j]; v1[j] = xr1[64 * j]; }
#pragma unroll
    for (int j = 0; j < 4; ++j) { s0 += (v0[j].x * v0[j].x + v0[j].y * v0[j].y) + (v0[j].z * v0[j].z + v0[j].w * v0[j].w); s1 += (v1[j].x * v1[j].x + v1[j].y * v1[j].y) + (v1[j].z * v1[j].z + v1[j].w * v1[j].w); }
#pragma unroll
    for (int o = 1; o < 64; o <<= 1) { s0 += __shfl_xor(s0, o); s1 += __shfl_xor(s1, o); }
    const float r0 = rsqrtf(s0 * (1.f / DM) + EPS), r1 = rsqrtf(s1 * (1.f / DM) + EPS);
    unsigned long long* p0 = (unsigned long long*)o0 + lane; unsigned long long* p1 = (unsigned long long*)o1 + lane;
#pragma unroll
    for (int j = 0; j < 4; ++j) { const int c = 4 * lane + 256 * j;
        const f32x4 g = *(const f32x4*)(gain + c);
        const f32x4 y0 = v0[j] * r0 * g * (*(const f32x4*)(sc0 + c) + 1.f) + *(const f32x4*)(sh0 + c);
        const f32x4 y1 = v1[j] * r1 * g * (*(const f32x4*)(sc1 + c) + 1.f) + *(const f32x4*)(sh1 + c);
        p0[64 * j] = (unsigned long long)pk2(y0.x, y0.y) | ((unsigned long long)pk2(y0.z, y0.w) << 32);
        p1[64 * j] = (unsigned long long)pk2(y1.x, y1.y) | ((unsigned long long)pk2(y1.z, y1.w) << 32); }
}
__device__ __forceinline__ void modulate_row_part(const float* xrow, float* xout, const float* part  , const float* gate, bf16* orow, const float* gain, const float* shift, const float* scale, int lane) {
    const f32x4* xr = (const f32x4*)xrow + lane;
    f32x4 v[4]; float s = 0.f;
#pragma unroll
    for (int j = 0; j < 4; ++j) { f32x4 p = (f32x4){0.f, 0.f, 0.f, 0.f};
#pragma unroll
        for (int sl = 0; sl < 8; ++sl) p += *((const f32x4*)(part + (size_t)sl * 2048 * 1024) + lane + 64 * j);
        v[j] = xr[64 * j] + *(const f32x4*)(gate + 4 * lane + 256 * j) * p;
        ((f32x4*)xout + lane)[64 * j] = v[j];
        s += (v[j].x * v[j].x + v[j].y * v[j].y) + (v[j].z * v[j].z + v[j].w * v[j].w); }
    const float r = rsqrtf(wave_sum(s) * (1.f / DM) + EPS);
    unsigned long long* o8 = (unsigned long long*)orow + lane;
#pragma unroll
    for (int j = 0; j < 4; ++j) { const int c = 4 * lane + 256 * j;
        const f32x4 g = *(const f32x4*)(gain + c), sh = *(const f32x4*)(shift + c), sc = *(const f32x4*)(scale + c);
        const f32x4 y = v[j] * r * g * (sc + 1.f) + sh;
        o8[64 * j] = (unsigned long long)pk2(y.x, y.y) | ((unsigned long long)pk2(y.z, y.w) << 32); }
}

constexpr int RS = 136;
constexpr int DVS = 64, NMT = DVS / 16;
constexpr int ML_QS = 0, ML_KS = 128 * RS * 2, ML_KT = 2 * 128 * RS * 2, ML_VT = 3 * 128 * RS * 2, ML_CS = ML_VT + DVS * RS * 2, ML_AV = ML_CS + (DVS + 16) * RS * 2, ML_END = ML_AV + 8 * 128 * 4;
static_assert(ML_END <= TAB_OFF, "mLSTM LDS");
#define MFMA16(a, b, c) __builtin_amdgcn_mfma_f32_16x16x32_bf16((a), (b), (c), 0, 0, 0)

__device__ __forceinline__ void mlstm_item(int item, const bf16* PM  , const float* GA, const float* BP, const float* CH, bf16* HF, bf16* HB, char* lds) {
    const int tid = opaque_tid(), lane = tid & 63, wv = tid >> 6, w = __builtin_amdgcn_readfirstlane(tid >> 6);
    const int chain = item >> 1, slice = item & 1, b = chain >> 3, h = (chain >> 1) & 3, dir = chain & 1;
    const int c16 = lane & 15, quad = lane >> 4;
    bf16* QS = (bf16*)(lds + ML_QS); bf16* KS = (bf16*)(lds + ML_KS); bf16* KT = (bf16*)(lds + ML_KT); bf16* VT = (bf16*)(lds + ML_VT); bf16* CS = (bf16*)(lds + ML_CS);
    float* AV = (float*)(lds + ML_AV) + wv * 128;
    bf16* Hout = dir ? HB : HF;
    const int ttv = (wv < 4) ? wv : 11 - wv, tt = __builtin_amdgcn_readfirstlane(ttv);
    const bf16* qs_f = QS + (16 * ttv + c16) * RS + 8 * quad;
    const bf16* cs_f = CS + c16 * RS + 8 * quad;
    const bf16* ks_f = KS + c16 * RS + 8 * quad;
    const bf16* vt4_f = VT + c16 * RS + 4 * quad;
    const bf16* vt8_f = VT + c16 * RS + 8 * quad;
    const bf16* kt_f = KT + (16 * wv + c16) * RS + 8 * quad;
    bf16* qs_w = QS + (2 * lane) * RS + 16 * wv;
    bf16* ks_w = KS + (2 * lane) * RS + 16 * wv;
    bf16* kt_w = KT + (16 * wv) * RS + 2 * lane;
    bf16* vt_w = VT + (8 * wv) * RS + 2 * lane;
    bf16* cs_w = CS + (4 * quad) * RS + 16 * wv + c16;
    const float* av_r = AV + 4 * quad;
    const int tl = 16 * ttv + c16;
    const float2* ga = (const float2*)(GA + (size_t)chain * KVLEN);
    const float2* bp = (const float2*)BP + (size_t)chain * KVLEN;
    const float2* ch = (const float2*)CH + chain * 34;
    for (int i = tid; i < (DVS + 16) * RS / 2; i += 512) ((unsigned*)CS)[i] = 0u;
    f32x4 Cacc[NMT + 1];
#pragma unroll
    for (int mt = 0; mt <= NMT; ++mt) Cacc[mt] = (f32x4){0.f, 0.f, 0.f, 0.f};
    float m_state = 0.f;
    const bf16x8 ones8 = (c16 == 0) ? (bf16x8){0x3F80, 0x3F80, 0x3F80, 0x3F80, 0x3F80, 0x3F80, 0x3F80, 0x3F80} : (bf16x8){0, 0, 0, 0, 0, 0, 0, 0};
    v4u rq[4], rk[4], rv0, rv1; float2 ra, rbp, rch;
#define ML_LOAD(CI) do { const int ci_ = (CI); const bool ic_ = ci_ < 2; const int cc_ = ic_ ? ci_ : ci_ - 2; const int len_ = ic_ ? TCX : TL; const int rb_ = ic_ ? ML + b * TCX : b * TL; \
        const int i0_ = 128 * cc_ + 2 * lane; const int t0_ = dir ? len_ - 1 - i0_ : i0_; const int t1_ = dir ? t0_ - 1 : t0_ + 1; \
        const bf16* p0_ = PM + (size_t)(rb_ + t0_) * 2048 + h * 128 + 16 * wv; const bf16* p1_ = PM + (size_t)(rb_ + t1_) * 2048 + h * 128 + 16 * wv; \
        rq[0] = *(const v4u*)p0_; rq[1] = *(const v4u*)(p0_ + 8); rq[2] = *(const v4u*)p1_; rq[3] = *(const v4u*)(p1_ + 8); \
        rk[0] = *(const v4u*)(p0_ + 512); rk[1] = *(const v4u*)(p0_ + 520); rk[2] = *(const v4u*)(p1_ + 512); rk[3] = *(const v4u*)(p1_ + 520); \
        rv0 = *(const v4u*)(PM + (size_t)(rb_ + t0_) * 2048 + 1024 + h * 128 + slice * DVS + 8 * wv); rv1 = *(const v4u*)(PM + (size_t)(rb_ + t1_) * 2048 + 1024 + h * 128 + slice * DVS + 8 * wv); \
        ra = ga[64 * ci_ + lane]; rbp = bp[128 * ci_ + tl]; rch = ch[ci_]; } while (0)
    ML_LOAD(0);
    __syncthreads();
    for (int ci = 0; ci < 34; ++ci) {
        const bool isctx = ci < 2; const int cc = isctx ? ci : ci - 2; const int len = isctx ? TCX : TL; const int rowbase = isctx ? ML + b * TCX : b * TL;
        const float a0 = ra.x, a1 = ra.y, b_last = rch.x, amax = rch.y, bt = rbp.x, pmt = rbp.y;
        const float m_new = fmaxf(b_last + m_state, b_last + amax);
        const float decay = __expf(b_last + m_state - m_new);
        const float w0 = __expf(a0 + b_last - m_new), w1 = __expf(a1 + b_last - m_new);
        const float m_t = bt + fmaxf(m_state, pmt);
        const float w_inter = __expf(bt + m_state - m_t);
        const float dbase = bt - m_t;
        ((float2*)AV)[lane] = make_float2(a0, a1);
        *(v4u*)(qs_w) = rq[0]; *(v4u*)(qs_w + 8) = rq[1]; *(v4u*)(qs_w + RS) = rq[2]; *(v4u*)(qs_w + RS + 8) = rq[3];
        *(v4u*)(ks_w) = rk[0]; *(v4u*)(ks_w + 8) = rk[1]; *(v4u*)(ks_w + RS) = rk[2]; *(v4u*)(ks_w + RS + 8) = rk[3];
#pragma unroll
        for (int half = 0; half < 2; ++half)
#pragma unroll
            for (int e = 0; e < 4; ++e) { const unsigned k0w = rk[half][e], k1w = rk[2 + half][e];
                *(unsigned*)(kt_w + (8 * half + 2 * e) * RS) = pk2(bflo(k0w) * w0, bflo(k1w) * w1);
                *(unsigned*)(kt_w + (8 * half + 2 * e + 1) * RS) = pk2(bfhi(k0w) * w0, bfhi(k1w) * w1); }
#pragma unroll
        for (int e = 0; e < 4; ++e) { *(unsigned*)(vt_w + (2 * e) * RS) = (rv0[e] & 0xffffu) | (rv1[e] << 16); *(unsigned*)(vt_w + (2 * e + 1) * RS) = (rv0[e] >> 16) | (rv1[e] & 0xffff0000u); }
        if (ci + 1 < 34) ML_LOAD(ci + 1);
        __syncthreads();
        int tlo_ = tl; asm volatile("" : "+v"(tlo_));
        bf16x8 qf[4];
#pragma unroll
        for (int kk = 0; kk < 4; ++kk) qf[kk] = *(const bf16x8*)(qs_f + 32 * kk);
        f32x4 ao[NMT + 1];
#pragma unroll
        for (int mt = 0; mt <= NMT; ++mt) { ao[mt] = (f32x4){0.f, 0.f, 0.f, 0.f};
#pragma unroll
            for (int kk = 0; kk < 4; ++kk) { const bf16x8 a = *(const bf16x8*)(cs_f + 16 * mt * RS + 32 * kk); ao[mt] = MFMA16(a, qf[kk], ao[mt]); }
            ao[mt] = ao[mt] * w_inter; }
#pragma unroll
        for (int jj = 0; jj < 4; ++jj) {
            if (2 * jj <= tt) {
                f32x4 sv[2];
#pragma unroll
                for (int u = 0; u < 2; ++u) { const int st = 2 * jj + u; sv[u] = (f32x4){0.f, 0.f, 0.f, 0.f};
                    if (st <= tt) {
#pragma unroll
                        for (int kk = 0; kk < 4; ++kk) { const bf16x8 a = *(const bf16x8*)(ks_f + 16 * st * RS + 32 * kk); sv[u] = MFMA16(a, qf[kk], sv[u]); }
                        const f32x4 av = *(const f32x4*)(av_r + 16 * st);
#pragma unroll
                        for (int j = 0; j < 4; ++j) { const int s = 16 * st + 4 * quad + j; const float p = sv[u][j] * __expf(dbase + av[j]); sv[u][j] = (s <= tlo_) ? p : 0.f; }
                    } }
                bf16x8 pb; { v4u t; t.x = pk2(sv[0][0], sv[0][1]); t.y = pk2(sv[0][2], sv[0][3]); t.z = pk2(sv[1][0], sv[1][1]); t.w = pk2(sv[1][2], sv[1][3]); pb = __builtin_bit_cast(bf16x8, t); }
#pragma unroll
                for (int mt = 0; mt < NMT; ++mt) {
                    const bf16x4 lo = *(const bf16x4*)(vt4_f + 16 * mt * RS + 32 * jj), hi = *(const bf16x4*)(vt4_f + 16 * mt * RS + 32 * jj + 16);
                    const bf16x8 a = __builtin_shufflevector(lo, hi, 0, 1, 2, 3, 4, 5, 6, 7);
                    ao[mt] = MFMA16(a, pb, ao[mt]); }
                ao[NMT] = MFMA16(ones8, pb, ao[NMT]);
            }
        }
        {
            const float den = __shfl(ao[NMT][0], c16);
            const float inv = __builtin_amdgcn_rcpf(fmaxf(fabsf(den), __expf(-m_t)));
            const int tokt = dir ? len - 1 - (128 * cc + tl) : 128 * cc + tl;
            bf16* hp = Hout + (size_t)(rowbase + tokt) * 512 + h * 128 + slice * DVS + 4 * quad;
#pragma unroll
            for (int mt = 0; mt < NMT; ++mt) { v2u o; o.x = pk2(ao[mt][0] * inv, ao[mt][1] * inv); o.y = pk2(ao[mt][2] * inv, ao[mt][3] * inv); *(v2u*)(hp + 16 * mt) = o; }
        }
#pragma unroll
        for (int mt = 0; mt <= NMT; ++mt) { Cacc[mt] = Cacc[mt] * decay;
#pragma unroll
            for (int kk = 0; kk < 4; ++kk) {
                const bf16x8 bk = *(const bf16x8*)(kt_f + 32 * kk);
                const bf16x8 a = (mt < NMT) ? *(const bf16x8*)(vt8_f + 16 * mt * RS + 32 * kk) : ones8;
                Cacc[mt] = MFMA16(a, bk, Cacc[mt]); } }
        m_state = m_new;
        __syncthreads();
#pragma unroll
        for (int mt = 0; mt <= NMT; ++mt)
#pragma unroll
            for (int j = 0; j < 4; ++j) cs_w[(16 * mt + j) * RS] = (bf16)f2bf(Cacc[mt][j]);
    }
#undef ML_LOAD
    __syncthreads();
}
__global__ void __launch_bounds__(512, 2) hybrid_fwd(Args args) {
    extern __shared__ __attribute__((aligned(16))) unsigned char lds[];
    cg::grid_group grid = cg::this_grid();
    const int tid = threadIdx.x, lane = tid & 63, wave = __builtin_amdgcn_readfirstlane(tid >> 6);
    const int G = gridDim.x; const int bx = blockIdx.x;
    const int vcu = (G % 8 == 0) ? (bx % 8) * (G / 8) + bx / 8 : bx;
    const int gw = vcu * 8 + wave, NGW = G * 8;
    if (tid == 0) {
        LAS unsigned long long* tab = (LAS unsigned long long*)((LAS unsigned char*)lds + TAB_OFF);
        tab[0] = (unsigned long long)args.in[0]; tab[1] = (unsigned long long)args.in[1]; tab[2] = (unsigned long long)args.in[2]; tab[3] = (unsigned long long)args.in[3];
        tab[4] = (unsigned long long)args.in[4]; tab[5] = (unsigned long long)args.in[5]; tab[6] = (unsigned long long)args.in[6]; tab[7] = (unsigned long long)args.in[7];
        tab[8] = (unsigned long long)args.in[8]; tab[9] = (unsigned long long)args.in[9]; tab[10] = (unsigned long long)args.in[10]; tab[11] = (unsigned long long)args.in[11];
        tab[12] = (unsigned long long)args.in[12]; tab[13] = (unsigned long long)args.in[13]; tab[14] = (unsigned long long)args.in[14]; tab[15] = (unsigned long long)args.in[15];
        tab[16] = (unsigned long long)args.in[16]; tab[17] = (unsigned long long)args.in[17]; tab[18] = (unsigned long long)args.out; tab[19] = (unsigned long long)args.ws;
    }
    if (tid == 0) { ((volatile LAS unsigned*)((LAS unsigned char*)lds + TAB_OFF + 224))[0] = 0u; ((volatile LAS unsigned*)((LAS unsigned char*)lds + TAB_OFF + 224))[1] = 0u; }
    __syncthreads();
    XcdBarrier bar = xcd_barrier_post((unsigned*)args.ws, (volatile LAS unsigned*)((LAS unsigned char*)lds + TAB_OFF + 224));
#define GSYNC() do { XcdBarrier b_; b_.bar = (unsigned*)rd_ptr(lds, 19); b_.x = xb_xcc_id(); b_.st = (volatile LAS unsigned*)((LAS unsigned char*)lds + TAB_OFF + 224); xcd_barrier(b_); } while (0)
#define INP(k) ((const float*)rd_ptr(lds, (k)))
#define WSP(off) ((unsigned char*)rd_ptr(lds, 19) + (off))
#define x_in INP(0)
#define c_in INP(1)
#define ctx_in INP(2)
#define cctx_in INP(3)
#define w_ada INP(4)
#define b_ada INP(5)
#define norm_mix INP(6)
#define norm_mlp INP(7)
#define w_in INP(8)
#define b_gates INP(9)
#define conv_qk INP(10)
#define q_norm INP(11)
#define k_norm INP(12)
#define mlstm_norm INP(13)
#define w_out INP(14)
#define w_mlp_in INP(15)
#define w_mlp_out INP(16)
#define norm_final INP(17)
#define MOD ((float*)WSP(WS_MOD))
#define WIN ((bf16*)WSP(WS_WIN))
#define WOUT ((bf16*)WSP(WS_WOUT))
#define W1 ((bf16*)WSP(WS_W1))
#define W2 ((bf16*)WSP(WS_W2))
#define X ((bf16*)WSP(WS_X))
#define XN ((bf16*)WSP(WS_XN))
#define HF ((bf16*)WSP(WS_XN))
#define HB ((bf16*)WSP(WS_HB))
#define AO ((bf16*)WSP(WS_AO))
#define PM ((bf16*)WSP(WS_PM))
#define KB ((bf16*)WSP(WS_K))
#define VB ((bf16*)WSP(WS_V))
#define GT ((float*)WSP(WS_G))
#define HH ((bf16*)WSP(WS_H))

        if (PHMASK & (1 << 0))
        for (int rep_ = 0; rep_ < REP_0; ++rep_)
    {
        float* sil = (float*)lds;
        float* red = (float*)(lds + 9 * 1024 * 4);
        for (int i = tid; i < 9 * 1024; i += 512) { const float v = (i < 8192) ? c_in[i] : cctx_in[i - 8192]; sil[i] = siluf_(v); }
        __syncthreads();
        for (int it = bx; it < DEPTH * 48; it += G) {
            const int l = it / 48, nb = it % 48; const int kq = tid >> 7, nn = tid & 127, n = nb * 128 + nn;
            const float* wp = w_ada + (size_t)l * 1024 * 6144 + (size_t)(kq * 256) * 6144 + n;
            float acc[9];
#pragma unroll
            for (int r = 0; r < 9; ++r) acc[r] = 0.f;
#pragma unroll 8
            for (int k = 0; k < 256; ++k) { const float wv = wp[(size_t)k * 6144];
#pragma unroll
                for (int r = 0; r < 9; ++r) acc[r] += sil[r * 1024 + kq * 256 + k] * wv; }
#pragma unroll
            for (int r = 0; r < 9; ++r) red[(kq * 9 + r) * 128 + nn] = acc[r];
            __syncthreads();
            for (int i = tid; i < 9 * 128; i += 512) { const int r = i >> 7, c = i & 127;
                const float s = red[(0 * 9 + r) * 128 + c] + red[(1 * 9 + r) * 128 + c] + red[(2 * 9 + r) * 128 + c] + red[(3 * 9 + r) * 128 + c];
                MOD[((size_t)l * 9 + r) * 6144 + nb * 128 + c] = s + b_ada[(size_t)l * 6144 + nb * 128 + c]; }
            __syncthreads();
        }
        {
            float* scr = (float*)(lds + wave * 8448);
            constexpr int I_IN = 16 * 96, I_OUT = 16 * 32, I_1 = 16 * 128, I_2 = 64 * 32;
            for (int it = gw; it < I_IN + I_OUT + I_1 + I_2; it += NGW) {
                int r = it;
                if (r < I_IN) { transpose_item(w_in, 1024, NIN, 96, WIN, scr, r, lane); continue; } r -= I_IN;
                if (r < I_OUT) { transpose_item(w_out, 1024, 1024, 32, WOUT, scr, r, lane); continue; } r -= I_OUT;
                if (r < I_1) { transpose_item(w_mlp_in, 1024, FF, 128, W1, scr, r, lane); continue; } r -= I_1;
                transpose_item(w_mlp_out, FF, 1024, 32, W2, scr, r, lane);
            }
        }
    }
    if (args.out == nullptr) grid.sync();
    GSYNC();

    for (int layer = 0; layer < DEPTH; ++layer) {
        const int tid = opaque_tid(), lane = tid & 63;
        const bool emit_ctx = layer < DEPTH - 1;
        const int Mout = emit_ctx ? MT : ML;
#define modl (MOD + (size_t)layer * 9 * 6144)
#define xlat (layer == 0 ? (const void*)x_in : (const void*)X)
#define xctx (layer == 0 ? (const void*)ctx_in : (const void*)(X + (size_t)ML * 1024))

        if (PHMASK & (1 << 1))
        for (int rep_ = 0; rep_ < REP_A; ++rep_)
        {
            float* scr = (float*)(lds + wave * 8448);
            constexpr int I_IN = 16 * 96, I_OUT = 16 * 32, I_1 = 16 * 128, I_2 = 64 * 32;
            if (layer > 0)
            for (int it = gw; it < I_IN + I_OUT + I_1 + I_2; it += NGW) {
                int r = it;
                if (r < I_IN) { transpose_item(w_in + (size_t)layer * 1024 * NIN, 1024, NIN, 96, WIN, scr, r, lane); continue; } r -= I_IN;
                if (r < I_OUT) { transpose_item(w_out + (size_t)layer * 1024 * 1024, 1024, 1024, 32, WOUT, scr, r, lane); continue; } r -= I_OUT;
                if (r < I_1) { transpose_item(w_mlp_in + (size_t)layer * 1024 * FF, 1024, FF, 128, W1, scr, r, lane); continue; } r -= I_1;
                transpose_item(w_mlp_out + (size_t)layer * FF * 1024, FF, 1024, 32, W2, scr, r, lane);
            }
            if (layer == 0) {
                for (int row = gw; row < ML; row += 4 * NGW)
                    modulate_rows4<false>(x_in, XN, row, NGW, modl, 0, 1024, norm_mix + layer * 1024, lane);
                for (int row = ML + gw; row < MT; row += NGW)
                    modulate_row<false>(ctx_in + (size_t)(row - ML) * 1024, XN + (size_t)row * 1024, norm_mix + layer * 1024, modl + 8 * 6144 + 0, modl + 8 * 6144 + 1024, lane);
            } else {
                for (int row = gw; row < ML; row += 4 * NGW)
                    modulate_rows4<true>(X, XN, row, NGW, modl, 0, 1024, norm_mix + layer * 1024, lane);
                if (rep_ + 1 >= REP_A)
                for (int row = ML + gw; row < MT; row += NGW)
                    modulate_row_part<true>(X + (size_t)row * 1024, X + (size_t)row * 1024, (const bf16*)rd_ptr(lds, 18) + (size_t)(row - ML) * 1024, MOD + ((size_t)(layer - 1) * 9 + 8) * 6144 + 5120,
                                            XN + (size_t)row * 1024, norm_mix + layer * 1024, modl + 8 * 6144 + 0, modl + 8 * 6144 + 1024, lane);
            }
        }
        GSYNC();

        if (PHMASK & (1 << 2))
        for (int rep_ = 0; rep_ < REP_B; ++rep_)
        {
            pg8::Gemm g{XN, WIN, MT, NINP, 1024, 0}; pg8::ThinLastOrder S; S.init(MT, G, bx);
            pg8::EpiIn E{AO, PM, (bf16*)rd_ptr(lds, 18), GT, b_gates + layer * 16};
            pg8::gemm_phase<pg8::EpiIn, pg8::ThinLastOrder, true, true, 11>((PG8_LAS unsigned char*)lds, g, S, E);
        }
        GSYNC();

        {
            const bf16* RAW = (const bf16*)rd_ptr(lds, 18);
            float cw[2][3][8];
#pragma unroll
            for (int p = 0; p < 2; ++p)
#pragma unroll
                for (int tap = 0; tap < 3; ++tap) { const float* cp = conv_qk + (size_t)layer * 3072 + tap * 1024 + 512 * p + 8 * lane;
                    const f32x4 c0 = *(const f32x4*)cp, c1 = *(const f32x4*)(cp + 4);
#pragma unroll
                    for (int e = 0; e < 4; ++e) { cw[p][tap][e] = c0[e]; cw[p][tap][4 + e] = c1[e]; } }
#define PC_CONV_ROWS(NR, ROWBASE, STRIDE) do { \
                v4u r0[NR][2], r1[NR][2], r2[NR][2]; \
                _Pragma("unroll") for (int q = 0; q < NR; ++q) { const int row = (ROWBASE) + q * (STRIDE); \
                    const bool islat = row < ML; const int t = islat ? row & 4095 : (row - ML) & 255; const int len = islat ? TL : TCX; \
                    const bool vm = t > 0, vp = t < len - 1; \
                    const bf16* rp = RAW + (size_t)row * 1024 + 8 * lane; \
                    const v4u z4 = (v4u){0u, 0u, 0u, 0u}; \
                    _Pragma("unroll") for (int p = 0; p < 2; ++p) { r1[q][p] = *(const v4u*)(rp + 512 * p); r0[q][p] = vm ? *(const v4u*)(rp + 512 * p - 1024) : z4; r2[q][p] = vp ? *(const v4u*)(rp + 512 * p + 1024) : z4; } } \
                _Pragma("unroll") for (int q = 0; q < NR; ++q) \
                    _Pragma("unroll") for (int p = 0; p < 2; ++p) { \
                        const float scl = p ? 0.08838834764831845f : 1.f; \
                        v4u o; \
                        _Pragma("unroll") for (int e = 0; e < 4; ++e) { \
                            const float x0 = cw[p][0][2 * e] * bflo(r0[q][p][e]) + cw[p][1][2 * e] * bflo(r1[q][p][e]) + cw[p][2][2 * e] * bflo(r2[q][p][e]); \
                            const float x1 = cw[p][0][2 * e + 1] * bfhi(r0[q][p][e]) + cw[p][1][2 * e + 1] * bfhi(r1[q][p][e]) + cw[p][2][2 * e + 1] * bfhi(r2[q][p][e]); \
                            const float y0 = x0 * __builtin_amdgcn_rcpf(1.f + __builtin_amdgcn_exp2f(-1.4426950408889634f * x0)) * scl; \
                            const float y1 = x1 * __builtin_amdgcn_rcpf(1.f + __builtin_amdgcn_exp2f(-1.4426950408889634f * x1)) * scl; \
                            o[e] = pk2(y0, y1); } \
                        *(v4u*)(PM + (size_t)((ROWBASE) + q * (STRIDE)) * 2048 + 512 * p + 8 * lane) = o; } } while (0)
            for (int row0 = gw; row0 < ML; row0 += 4 * NGW) PC_CONV_ROWS(4, row0, NGW);
            for (int row0 = ML + gw; row0 < MT; row0 += NGW) PC_CONV_ROWS(1, row0, 0);
#undef PC_CONV_ROWS
            float* GAp = (float*)WSP(WS_GA); float* BPp = (float*)WSP(WS_BP); float* CHp = (float*)WSP(WS_CH); const float* gates = GT;
            for (int it = gw; it < 64 * 34; it += NGW) {
                const int chain = it / 34, ci = it - chain * 34; const int b = chain >> 3, h = (chain >> 1) & 3, dir = chain & 1;
                const bool isctx = ci < 2; const int cc = isctx ? ci : ci - 2; const int len = isctx ? TCX : TL; const int rowbase = isctx ? ML + b * TCX : b * TL;
                const int gi = (dir ? 8 : 0) + h, gf = (dir ? 12 : 4) + h;
                const int i0 = 128 * cc + 2 * lane;
                const int tok0 = dir ? len - 1 - i0 : i0, tok1 = dir ? tok0 - 1 : tok0 + 1;
                const float* g0 = gates + (size_t)(rowbase + tok0) * 16; const float* g1 = gates + (size_t)(rowbase + tok1) * 16;
                const float ig0 = g0[gi], ig1 = g1[gi], lf0 = logsigmoidf_(g0[gf]), lf1 = logsigmoidf_(g1[gf]);
                float sc = lf0 + lf1;
#pragma unroll
                for (int o = 1; o < 64; o <<= 1) { const float tt = __shfl_up(sc, o); if (lane >= o) sc += tt; }
                const float b1 = sc, b0 = sc - lf1;
                const float a0 = ig0 - b0, a1 = ig1 - b1;
                float sm = fmaxf(a0, a1);
#pragma unroll
                for (int o = 1; o < 64; o <<= 1) { const float tt = __shfl_up(sm, o); if (lane >= o) sm = fmaxf(sm, tt); }
                float pme = __shfl_up(sm, 1); if (lane == 0) pme = -INFINITY;
                const float pm0 = fmaxf(pme, a0), pm1 = sm;
                const size_t base = (size_t)chain * KVLEN + 128 * ci + 2 * lane;
                *(float2*)(GAp + base) = make_float2(a0, a1);
                *(f32x4*)(BPp + 2 * base) = (f32x4){b0, pm0, b1, pm1};
                if (lane == 63) *(float2*)(CHp + 2 * (chain * 34 + ci)) = make_float2(b1, sm);
            }
        }
        {
            float2* rt = (float2*)lds;
            for (int i = tid; i < 1024; i += 512) { const int pp = i >> 4, fi = i & 15;
                const float invf = exp2f(-(float)(2 * fi) * (13.287712379549449f / 32.f)); float sv, cv; sincosf((float)pp * invf, &sv, &cv); rt[i] = make_float2(cv, sv); }
            __syncthreads();
            const int l8 = lane & 7, lk = lane & 15;
            float qg[8], kg[8];
#pragma unroll
            for (int e = 0; e < 8; ++e) { qg[e] = q_norm[layer * 64 + 8 * l8 + e] * attn_body::C2; kg[e] = k_norm[layer * 64 + 8 * l8 + e]; }
#define PC_QK_ROWS(NR, ROWBASE, STRIDE) do { \
                v4u rawq[NR], rawk[NR], rawv[NR]; \
                _Pragma("unroll") for (int q = 0; q < NR; ++q) { const bf16* ar = AO + (size_t)((ROWBASE) + q * (STRIDE)) * 1024; \
                    rawq[q] = *(const v4u*)(ar + 8 * lane); rawk[q] = *(const v4u*)(ar + 512 + 8 * lk); rawv[q] = *(const v4u*)(ar + 640 + 8 * lk); } \
                _Pragma("unroll") for (int q = 0; q < NR; ++q) { \
                    const int row = (ROWBASE) + q * (STRIDE); \
                    const bool islat = row < ML; const int b = islat ? row >> 12 : (row - ML) >> 8; const int t = islat ? row & 4095 : (row - ML) & 255; \
                    const int pos = islat ? TCX + t : t; \
                    bf16* ar = AO + (size_t)row * 1024; \
                    float cs[4], sn[4]; \
                    { const int pp = (l8 < 4) ? (t >> 6) : (t & 63); const f32x4* tp = (const f32x4*)(rt + pp * 16 + 4 * (l8 & 3)); \
                      const f32x4 t0 = tp[0], t1 = tp[1]; \
                      if (islat) { cs[0] = t0[0]; sn[0] = t0[1]; cs[1] = t0[2]; sn[1] = t0[3]; cs[2] = t1[0]; sn[2] = t1[1]; cs[3] = t1[2]; sn[3] = t1[3]; } \
                      else { cs[0] = cs[1] = cs[2] = cs[3] = 1.f; sn[0] = sn[1] = sn[2] = sn[3] = 0.f; } } \
                    { float v[8]; \
                        _Pragma("unroll") for (int e = 0; e < 4; ++e) { v[2 * e] = bflo(rawq[q][e]); v[2 * e + 1] = bfhi(rawq[q][e]); } \
                        float ss = 0.f; \
                        _Pragma("unroll") for (int e = 0; e < 8; ++e) ss += v[e] * v[e]; \
                        ss += __shfl_xor(ss, 1); ss += __shfl_xor(ss, 2); ss += __shfl_xor(ss, 4); \
                        const float r = rsqrtf(ss * (1.f / 64.f) + EPS); \
                        v4u o; \
                        _Pragma("unroll") for (int j = 0; j < 4; ++j) { const float x0 = v[2 * j] * r * qg[2 * j], x1 = v[2 * j + 1] * r * qg[2 * j + 1]; \
                            o[j] = pk2(x0 * cs[j] - x1 * sn[j], x0 * sn[j] + x1 * cs[j]); } \
                        *(v4u*)(ar + 8 * lane) = o; } \
                    { float v[8]; \
                        _Pragma("unroll") for (int e = 0; e < 4; ++e) { v[2 * e] = bflo(rawk[q][e]); v[2 * e + 1] = bfhi(rawk[q][e]); } \
                        float ss = 0.f; \
                        _Pragma("unroll") for (int e = 0; e < 8; ++e) ss += v[e] * v[e]; \
                        ss += __shfl_xor(ss, 1); ss += __shfl_xor(ss, 2); ss += __shfl_xor(ss, 4); \
                        const float r = rsqrtf(ss * (1.f / 64.f) + EPS); \
                        v4u o; \
                        _Pragma("unroll") for (int j = 0; j < 4; ++j) { const float x0 = v[2 * j] * r * kg[2 * j], x1 = v[2 * j + 1] * r * kg[2 * j + 1]; \
                            o[j] = pk2(x0 * cs[j] - x1 * sn[j], x0 * sn[j] + x1 * cs[j]); } \
                        const size_t kvrow = ((size_t)b * KVLEN + pos) * 128; \
                        if (lane < 16) *(v4u*)(KB + kvrow + 8 * lk) = o; \
                        else if (lane < 32) *(v4u*)(VB + kvrow + 8 * lk) = rawv[q]; } } } while (0)
            for (int row0 = gw; row0 < ML; row0 += 4 * NGW) PC_QK_ROWS(4, row0, NGW);
            for (int row0 = ML + gw; row0 < MT; row0 += NGW) PC_QK_ROWS(1, row0, 0);
#undef PC_QK_ROWS
        }
        GSYNC();

        {
            unsigned* ctr = (unsigned*)WSP(14336) + 64 * layer;
            unsigned* mdone = (unsigned*)WSP(15360) + 64 * layer;
            bool had_item = false;
            for (int item = (vcu & 1) ? 128 : (vcu >> 1); item < 128; item += (G >> 1)) {
                mlstm_item(item, PM, (const float*)WSP(WS_GA), (const float*)WSP(WS_BP), (const float*)WSP(WS_CH), HF, HB, (char*)lds); had_item = true; }
            if (had_item) {
                asm volatile("s_waitcnt vmcnt(0)" ::: "memory"); __syncthreads();
                if (tid == 0) { __builtin_amdgcn_fence(__ATOMIC_RELEASE, "agent"); asm volatile("s_waitcnt vmcnt(0)" ::: "memory");
                    int n_it = 0; for (int item = (vcu & 1) ? 128 : (vcu >> 1); item < 128; item += (G >> 1)) ++n_it;
                    __hip_atomic_fetch_add(mdone, (unsigned)n_it, __ATOMIC_RELAXED, __HIP_MEMORY_SCOPE_AGENT); }
            }
            __syncthreads();
            volatile LAS unsigned* uw = (volatile LAS unsigned*)((LAS unsigned char*)lds + TAB_OFF + 232);
            const int NPE = Mout / 128;
            const int total = 1024 + NPE + (emit_ctx ? 64 : 0);
            bool acquired = false;
            for (;;) {
                if (tid == 0) uw[0] = __hip_atomic_fetch_add(ctr, 1u, __ATOMIC_RELAXED, __HIP_MEMORY_SCOPE_AGENT);
                __syncthreads();
                const int u = __builtin_amdgcn_readfirstlane((int)uw[0]);
                if (u >= total) break;
                if (u < 1024) {
                    const int bkv = u >> 6, rem = u & 63, hq = rem >> 4, qb = rem & 15; const int b = bkv >> 1, kvh = bkv & 1, h = kvh * 4 + hq;
                    attn_body::attn_unit<8>((attn_body::bf16*)(AO + ((size_t)b * TL + qb * 256) * 1024 + h * 64), (attn_body::bf16*)(AO + ((size_t)b * TL + qb * 256) * 1024 + h * 64),
                                            (const attn_body::bf16*)(KB + (size_t)b * KVLEN * 128 + kvh * 64), (const attn_body::bf16*)(VB + (size_t)b * KVLEN * 128 + kvh * 64), KVLEN / 64, (char*)lds);
                } else if (u < 1024 + NPE) {
                    if (!acquired) {
                        if (tid == 0) { unsigned sp = 0; while (__hip_atomic_load(mdone, __ATOMIC_RELAXED, __HIP_MEMORY_SCOPE_AGENT) < 128u && ++sp < (1u << 22)) __builtin_amdgcn_s_sleep(8);
                            __builtin_amdgcn_fence(__ATOMIC_ACQUIRE, "agent"); asm volatile("s_waitcnt vmcnt(0)" ::: "memory"); }
                        __syncthreads(); acquired = true;
                    }
                    const int r0 = (u - 1024) * 128 + wave * 16;
                    float gnv[8];
#pragma unroll
                    for (int e = 0; e < 8; ++e) gnv[e] = mlstm_norm[layer * 512 + 8 * lane + e];
                    for (int rr = 0; rr < 16; rr += 8) {
                        const int row = r0 + rr;
                        v4u a[8], bq[8], og[8];
#pragma unroll
                        for (int q = 0; q < 8; ++q) { a[q] = *(const v4u*)(HF + (size_t)(row + q) * 512 + 8 * lane); bq[q] = *(const v4u*)(HB + (size_t)(row + q) * 512 + 8 * lane); og[q] = *(const v4u*)(PM + (size_t)(row + q) * 2048 + 1536 + 8 * lane); }
#pragma unroll
                        for (int q = 0; q < 8; ++q) {
                            float v[8]; float ss = 0.f;
#pragma unroll
                            for (int e = 0; e < 4; ++e) { v[2 * e] = bflo(a[q][e]) + bflo(bq[q][e]); v[2 * e + 1] = bfhi(a[q][e]) + bfhi(bq[q][e]); }
#pragma unroll
                            for (int e = 0; e < 8; ++e) ss += v[e] * v[e];
                            ss += __shfl_xor(ss, 1); ss += __shfl_xor(ss, 2); ss += __shfl_xor(ss, 4); ss += __shfl_xor(ss, 8);
                            const float r = rsqrtf(ss * (1.f / 128.f) + EPS);
                            v4u o;
#pragma unroll
                            for (int e = 0; e < 4; ++e) { const float s0 = __builtin_amdgcn_rcpf(1.f + __builtin_amdgcn_exp2f(-1.4426950408889634f * bflo(og[q][e]))), s1 = __builtin_amdgcn_rcpf(1.f + __builtin_amdgcn_exp2f(-1.4426950408889634f * bfhi(og[q][e])));
                                o[e] = pk2(s0 * v[2 * e] * r * gnv[2 * e], s1 * v[2 * e + 1] * r * gnv[2 * e + 1]); }
                            *(v4u*)(AO + (size_t)(row + q) * 1024 + 512 + 8 * lane) = o;
                        }
                    }
                    __syncthreads();
                } else {
                    const int c = u - 1024 - NPE, b = c >> 3, h = c & 7, kvh = h >> 2;
                    attn_body::attn_unit<8>((attn_body::bf16*)(AO + ((size_t)ML + b * TCX) * 1024 + h * 64), (attn_body::bf16*)(AO + ((size_t)ML + b * TCX) * 1024 + h * 64),
                                            (const attn_body::bf16*)(KB + (size_t)b * KVLEN * 128 + kvh * 64), (const attn_body::bf16*)(VB + (size_t)b * KVLEN * 128 + kvh * 64), TCX / 64, (char*)lds);
                }
            }
        }
        GSYNC();

        if (PHMASK & (1 << 6))
        for (int rep_ = 0; rep_ < REP_F; ++rep_)
        {
            pg8::Gemm g{AO, WOUT, Mout, 1024, 1024, 0}; pg8::SplitOrder S; S.init(G, bx, 1024, emit_ctx);
            pg8::EpiRes E{xlat, xctx, (rep_ + 1 < REP_F) ? XN : X, modl + 2048, (rep_ + 1 < REP_F) ? 32767u : 0xffffffffu, (bf16*)rd_ptr(lds, 18), layer > 0};
            pg8::gemm_phase<pg8::EpiRes, pg8::SplitOrder, true, true>((PG8_LAS unsigned char*)lds, g, S, E);
        }
        GSYNC();

        if (PHMASK & (1 << 7))
        for (int rep_ = 0; rep_ < REP_G; ++rep_)
        {
            for (int row = gw; row < ML; row += 4 * NGW)
                modulate_rows4<true>(X, XN, row, NGW, modl, 3072, 4096, norm_mlp + layer * 1024, lane);
            if (emit_ctx && rep_ + 1 >= REP_G)
                for (int row = ML + gw; row < MT; row += NGW) {
                    if (layer == 0) modulate_row_part<false>(ctx_in + (size_t)(row - ML) * 1024, X + (size_t)row * 1024, (const bf16*)rd_ptr(lds, 18) + (size_t)(row - ML) * 1024, modl + 8 * 6144 + 2048,
                                                             XN + (size_t)row * 1024, norm_mlp + layer * 1024, modl + 8 * 6144 + 3072, modl + 8 * 6144 + 4096, lane);
                    else modulate_row_part<true>(X + (size_t)row * 1024, X + (size_t)row * 1024, (const bf16*)rd_ptr(lds, 18) + (size_t)(row - ML) * 1024, modl + 8 * 6144 + 2048,
                                                 XN + (size_t)row * 1024, norm_mlp + layer * 1024, modl + 8 * 6144 + 3072, modl + 8 * 6144 + 4096, lane);
                }
        }
        GSYNC();

        if (PHMASK & (1 << 8))
        for (int rep_ = 0; rep_ < REP_H; ++rep_)
        {
            pg8::Gemm g{XN, W1, Mout, FF, 1024, 0}; pg8::StaticOrder S; S.init(Mout, FF, G, bx); S.ntf = 16;
            pg8::EpiUp E{HH};
            pg8::gemm_phase<pg8::EpiUp, pg8::StaticOrder, true, true>((PG8_LAS unsigned char*)lds, g, S, E);
        }
        GSYNC();

        if (PHMASK & (1 << 9))
        for (int rep_ = 0; rep_ < REP_I; ++rep_)
        {
            pg8::Gemm g{HH, W2, Mout, 1024, FF, 1}; pg8::SplitOrder S; S.init(G, bx, FF, emit_ctx);
            pg8::EpiRes E{X, X + (size_t)ML * 1024, (rep_ + 1 < REP_I) ? XN : X, modl + 5120, (rep_ + 1 < REP_I) ? 32767u : 0xffffffffu, (bf16*)rd_ptr(lds, 18), 1};
            pg8::gemm_phase<pg8::EpiRes, pg8::SplitOrder, true, true>((PG8_LAS unsigned char*)lds, g, S, E);
        }
        GSYNC();
    }

        if (PHMASK & (1 << 10))
        for (int rep_ = 0; rep_ < REP_Z; ++rep_)
    for (int row = gw; row < ML; row += 4 * NGW) {
        f32x4 v[4][4]; float ss[4];
#pragma unroll
        for (int q = 0; q < 4; ++q)
#pragma unroll
            for (int j = 0; j < 4; ++j) v[q][j] = ldx4<true>(X + (size_t)(row + q * NGW) * 1024, lane + 64 * j);
#pragma unroll
        for (int q = 0; q < 4; ++q) { float a = 0.f;
#pragma unroll
            for (int j = 0; j < 4; ++j) a += (v[q][j].x * v[q][j].x + v[q][j].y * v[q][j].y) + (v[q][j].z * v[q][j].z + v[q][j].w * v[q][j].w);
            ss[q] = a; }
#pragma unroll
        for (int o = 1; o < 64; o <<= 1) {
#pragma unroll
            for (int q = 0; q < 4; ++q) ss[q] += __shfl_xor(ss[q], o); }
#pragma unroll
        for (int q = 0; q < 4; ++q) { const float r = rsqrtf(ss[q] * (1.f / DM) + EPS);
            f32x4* o = (f32x4*)((float*)rd_ptr(lds, 18) + (size_t)(row + q * NGW) * 1024) + lane;
#pragma unroll
            for (int j = 0; j < 4; ++j) o[64 * j] = v[q][j] * r * *(const f32x4*)(norm_final + 4 * lane + 256 * j); }
    }
}

extern "C" void kernel_launch(void* const* d_in, const int* in_sizes, int n_in, void* d_out, int out_size, void* d_ws, size_t ws_size, hipStream_t stream) {
    static int grid = 0;
    if (grid == 0) {
        if (n_in != 18 || in_sizes[0] != ML * DM || out_size != ML * DM || ws_size < WS_END) {
            fprintf(stderr, "kernel_launch: unexpected shapes: n_in %d in0 %d out %d ws %zu (need %zu)\n", n_in, n_in > 0 ? in_sizes[0] : -1, out_size, ws_size, (size_t)WS_END); grid = -1; return; }
        int dev = 0, cus = 0, per_cu = 0;
        (void)hipGetDevice(&dev); (void)hipDeviceGetAttribute(&cus, hipDeviceAttributeMultiprocessorCount, dev);
        if (hipFuncSetAttribute((const void*)hybrid_fwd, hipFuncAttributeMaxDynamicSharedMemorySize, LDS_BYTES) != hipSuccess) { fprintf(stderr, "kernel_launch: hipFuncSetAttribute failed\n"); grid = -1; return; }
        if (hipOccupancyMaxActiveBlocksPerMultiprocessor(&per_cu, (const void*)hybrid_fwd, 512, LDS_BYTES) != hipSuccess || per_cu < 1) { fprintf(stderr, "kernel_launch: occupancy query says %d\n", per_cu); per_cu = 1; }
        (void)hipGetLastError();
        if (cus != 256) { fprintf(stderr, "kernel_launch: built for 256 CUs (MI355X), found %d; nothing launched\n", cus); grid = -1; return; }
        grid = cus * 1;
    }
    if (grid < 0) return;
    if (hipMemsetAsync(d_ws, 0, 16384, stream) != hipSuccess) { fprintf(stderr, "kernel_launch: memset failed\n"); return; }
    Args a{};
    for (int i = 0; i < 18; ++i) a.in[i] = (const float*)d_in[i];
    a.out = (float*)d_out; a.ws = (unsigned char*)d_ws;
    void* kargs[] = {&a};
    hipError_t e = hipLaunchCooperativeKernel((const void*)hybrid_fwd, dim3(grid), dim3(512), kargs, LDS_BYTES, stream);
    if (e != hipSuccess) fprintf(stderr, "kernel_launch: cooperative launch failed: %s (grid %d)\n", hipGetErrorString(e), grid);
}
```
